# Optimizing an MI355X kernel written in HIP

```python
import math
import jax, jax.numpy as jnp
from jax import lax
import numpy as np

D_MODEL = 1024
BATCH = 4
SEQ = 8192
DEPTH = 2

GRID_W = 64
ROPE_THETA = 10000.0
BLK = 128
N_BRANCH = 4
HEAD_DIM = 64
BRANCH_W = 512
LN_EPS = 1e-5
NEG_INF = -1e30

SWA_HEADS = 8
SWA_KV_HEADS = 2
SWA_WINDOW = 128
MLA_HEADS = 8
MLA_Q_RANK = 384
MLA_KV_RANK = 256
MLA_NOPE = 64
MLA_ROPE = 32
MLA_V = 64
DIFF_HEADS = 4
DIFF_QK = 64
DIFF_V = 128
NAT_HEADS = 8
NAT_KR_MAX = 8
NAT_KC = 16
PEER_HEADS = 8
PEER_NKEYS = 128
PEER_EXPERTS = PEER_NKEYS * PEER_NKEYS
PEER_DKEY = 256
PEER_TOPK = 16
PEER_TOK_BLK = 128

DN_ALPHA = (2 * DEPTH) ** 0.25
DN_BETA = (8 * DEPTH) ** -0.25

IN_WIDTHS = (
    SWA_HEADS * HEAD_DIM, SWA_KV_HEADS * HEAD_DIM, SWA_KV_HEADS * HEAD_DIM,
    MLA_Q_RANK, MLA_KV_RANK, MLA_ROPE,
    DIFF_HEADS * 2 * DIFF_QK, DIFF_HEADS * 2 * DIFF_QK, DIFF_HEADS * DIFF_V,
    NAT_HEADS * HEAD_DIM, NAT_HEADS * HEAD_DIM, NAT_HEADS * HEAD_DIM,
)
IN_SPLITS = tuple(int(v) for v in np.cumsum(IN_WIDTHS)[:-1])
D_IN = int(sum(IN_WIDTHS))

kernel_name = "hybrid_gated_parallel_mixers_peer_encoder"


def layer_norm(x, g=None, b=None):
    xf = x.astype(jnp.float32)
    mu = jnp.mean(xf, axis=-1, keepdims=True)
    var = jnp.mean(jnp.square(xf - mu), axis=-1, keepdims=True)
    y = (xf - mu) * lax.rsqrt(var + LN_EPS)
    if g is not None:
        y = y * g.astype(jnp.float32) + b.astype(jnp.float32)
    return y.astype(x.dtype)


def rms_norm(x, g):
    xf = x.astype(jnp.float32)
    y = xf * lax.rsqrt(jnp.mean(jnp.square(xf), axis=-1, keepdims=True) + LN_EPS)
    return (y * g.astype(jnp.float32)).astype(x.dtype)


def modulate(x, shift, scale):
    return layer_norm(x) * (1.0 + scale[:, None, :]) + shift[:, None, :]


def rope_tables(seq, dim):
    inv = ROPE_THETA ** (-jnp.arange(0, dim, 2, dtype=jnp.float32) / dim)
    ang = jnp.arange(seq, dtype=jnp.float32)[:, None] * inv[None, :]
    return jnp.cos(ang), jnp.sin(ang)


def apply_rope(t, cos, sin):
    t1, t2 = jnp.split(t, 2, axis=-1)
    cs = cos[None, :, None, :].astype(t.dtype)
    sn = sin[None, :, None, :].astype(t.dtype)
    return jnp.concatenate([t1 * cs - t2 * sn, t1 * sn + t2 * cs], axis=-1)


def qblock(a, i):
    return lax.dynamic_slice_in_dim(a, i * BLK, BLK, axis=1)


def unblock(out, b, s):
    return jnp.moveaxis(out, 0, 1).reshape(b, s, -1)


def swa_attention(q, k, v, sink, cos, sin):
    b, s, hq, d = q.shape
    hkv = k.shape[2]
    grp = hq // hkv
    q = apply_rope(q, cos, sin)
    k = apply_rope(k, cos, sin)
    pad = ((0, 0), (SWA_WINDOW, SWA_WINDOW), (0, 0), (0, 0))
    kp = jnp.pad(k, pad)
    vp = jnp.pad(v, pad)
    span = BLK + 2 * SWA_WINDOW
    sink_f = sink.astype(jnp.float32).reshape(hkv, grp)
    scale = d ** -0.5

    def block(i):
        s0 = i * BLK
        qb = qblock(q, i).reshape(b, BLK, hkv, grp, d)
        kb = lax.dynamic_slice_in_dim(kp, s0, span, axis=1)
        vb = lax.dynamic_slice_in_dim(vp, s0, span, axis=1)
        logits = jnp.einsum('bqkgd,bskd->bkgqs', qb, kb).astype(jnp.float32) * scale
        qpos = s0 + jnp.arange(BLK)
        kpos = s0 - SWA_WINDOW + jnp.arange(span)
        valid = ((jnp.abs(qpos[:, None] - kpos[None, :]) <= SWA_WINDOW)
                 & (kpos >= 0)[None, :] & (kpos < s)[None, :])
        logits = jnp.where(valid, logits, NEG_INF)
        sink_col = jnp.broadcast_to(sink_f[None, :, :, None, None], (b, hkv, grp, BLK, 1))
        p = jax.nn.softmax(jnp.concatenate([logits, sink_col], axis=-1), axis=-1)[..., :span]
        o = jnp.einsum('bkgqs,bskd->bqkgd', p.astype(v.dtype), vb)
        return o.reshape(b, BLK, hq * d)

    return unblock(lax.map(block, jnp.arange(s // BLK)), b, s)


def mla_attention(cq, ckv, krope, q_norm, q_up, kv_norm, kv_up, cos, sin):
    b, s, _ = cq.shape
    q = (rms_norm(cq, q_norm) @ q_up).reshape(b, s, MLA_HEADS, MLA_NOPE + MLA_ROPE)
    q_nope = q[..., :MLA_NOPE]
    q_rope = apply_rope(q[..., MLA_NOPE:], cos, sin)
    kv = (rms_norm(ckv, kv_norm) @ kv_up).reshape(b, s, MLA_HEADS, MLA_NOPE + MLA_V)
    k_nope = kv[..., :MLA_NOPE]
    v = kv[..., MLA_NOPE:]
    k_rope = apply_rope(krope[:, :, None, :], cos, sin)[:, :, 0]
    scale = (MLA_NOPE + MLA_ROPE) ** -0.5

    def block(i):
        logits = (jnp.einsum('bqhd,bshd->bhqs', qblock(q_nope, i), k_nope)
                  + jnp.einsum('bqhr,bsr->bhqs', qblock(q_rope, i), k_rope)).astype(jnp.float32) * scale
        p = jax.nn.softmax(logits, axis=-1)
        o = jnp.einsum('bhqs,bshd->bqhd', p.astype(v.dtype), v)
        return o.reshape(b, BLK, MLA_HEADS * MLA_V)

    return unblock(lax.map(block, jnp.arange(s // BLK)), b, s)


def diff_attention(q, k, v, lq1, lk1, lq2, lk2, subln, lambda_init, cos, sin):
    b, s, _ = q.shape
    q = apply_rope(q.reshape(b, s, DIFF_HEADS * 2, DIFF_QK), cos, sin).reshape(b, s, DIFF_HEADS, 2, DIFF_QK)
    k = apply_rope(k.reshape(b, s, DIFF_HEADS * 2, DIFF_QK), cos, sin).reshape(b, s, DIFF_HEADS, 2, DIFF_QK)
    v = v.reshape(b, s, DIFF_HEADS, DIFF_V)
    f32 = jnp.float32
    lam = (jnp.exp(jnp.sum(lq1.astype(f32) * lk1.astype(f32)))
           - jnp.exp(jnp.sum(lq2.astype(f32) * lk2.astype(f32))) + lambda_init)
    scale = DIFF_QK ** -0.5

    def block(i):
        logits = jnp.einsum('bqhmd,bshmd->bhmqs', qblock(q, i), k).astype(f32) * scale
        p = jax.nn.softmax(logits, axis=-1)
        a = p[:, :, 0] - lam * p[:, :, 1]
        o = jnp.einsum('bhqs,bshd->bqhd', a.astype(v.dtype), v)
        o = rms_norm(o, subln) * (1.0 - lambda_init)
        return o.reshape(b, BLK, DIFF_HEADS * DIFF_V)

    return unblock(lax.map(block, jnp.arange(s // BLK)), b, s)


def neighborhood_attention(q, k, v, rpb):
    b, s, _ = q.shape
    rows = s // GRID_W
    kr = min(NAT_KR_MAX, rows)
    grid = (b, rows, GRID_W, NAT_HEADS, HEAD_DIM)
    q = q.reshape(grid)
    k = k.reshape(grid)
    v = v.reshape(grid)
    cols = jnp.arange(GRID_W)
    col_start = jnp.clip(cols - NAT_KC // 2, 0, GRID_W - NAT_KC)
    col_idx = col_start[:, None] + jnp.arange(NAT_KC)[None, :]
    col_off = col_idx - cols[:, None] + (NAT_KC - 1)
    rpb_f = rpb.astype(jnp.float32)
    scale = HEAD_DIM ** -0.5

    def row(r):
        r0 = jnp.clip(r - kr // 2, 0, rows - kr)
        kband = lax.dynamic_slice_in_dim(k, r0, kr, axis=1)[:, :, col_idx]
        vband = lax.dynamic_slice_in_dim(v, r0, kr, axis=1)[:, :, col_idx]
        qr = lax.dynamic_index_in_dim(q, r, axis=1, keepdims=False)
        logits = jnp.einsum('bjhd,brjkhd->bhjrk', qr, kband).astype(jnp.float32) * scale
        row_off = r0 + jnp.arange(kr) - r + (NAT_KR_MAX - 1)
        bias = rpb_f[:, row_off[:, None, None], col_off[None, :, :]]
        logits = logits + jnp.transpose(bias, (0, 2, 1, 3))[None]
        p = jax.nn.softmax(logits.reshape(b, NAT_HEADS, GRID_W, kr * NAT_KC), axis=-1)
        p = p.reshape(b, NAT_HEADS, GRID_W, kr, NAT_KC)
        o = jnp.einsum('bhjrk,brjkhd->bjhd', p.astype(v.dtype), vband)
        return o.reshape(b, GRID_W, NAT_HEADS * HEAD_DIM)

    return unblock(lax.map(row, jnp.arange(rows)), b, s)


def peer_ffn(u, wq, keys, u_tab, v_tab):
    b, s, d = u.shape
    q = (u @ wq).reshape(b, s, PEER_HEADS, 2, PEER_DKEY // 2)
    scores = jnp.einsum('bshpk,hpnk->bshpn', q, keys).astype(jnp.float32)
    sub_s, sub_i = lax.top_k(scores, PEER_TOPK)
    cand_s = (sub_s[..., 0, :, None] + sub_s[..., 1, None, :]).reshape(b, s, PEER_HEADS, PEER_TOPK * PEER_TOPK)
    cand_i = (sub_i[..., 0, :, None] * PEER_NKEYS + sub_i[..., 1, None, :]).reshape(b, s, PEER_HEADS, PEER_TOPK * PEER_TOPK)
    top_s, pos = lax.top_k(cand_s, PEER_TOPK)
    eidx = jnp.take_along_axis(cand_i, pos, axis=-1)
    gates = jax.nn.softmax(top_s, axis=-1)
    nb = (b * s) // PEER_TOK_BLK
    ub = u.reshape(nb, PEER_TOK_BLK, d)
    ib = eidx.reshape(nb, PEER_TOK_BLK, PEER_HEADS, PEER_TOPK)
    gb = gates.reshape(nb, PEER_TOK_BLK, PEER_HEADS, PEER_TOPK)

    def blk(args):
        ut, it, gt = args
        ue = u_tab[it]
        h = jax.nn.gelu(jnp.einsum('td,thkd->thk', ut, ue).astype(jnp.float32), approximate=False)
        w = (gt * h).astype(ut.dtype)
        return jnp.einsum('thk,thkd->td', w, v_tab[it])

    return lax.map(blk, (ub, ib, gb)).reshape(b, s, d)


def setup_inputs(seed: int = 0) -> dict:
    key = jax.random.key(seed)
    ks = jax.random.split(key, 32)
    L, D = DEPTH, D_MODEL

    def nrm(k, shape, std):
        return std * jax.random.normal(k, shape, jnp.float32)

    def gain(k, shape):
        return 1.0 + 0.05 * jax.random.normal(k, shape, jnp.float32)

    return {
        "x": nrm(ks[0], (BATCH, SEQ, D), 1.0),
        "c": nrm(ks[1], (BATCH, D), 1.0),
        "ada_w": nrm(ks[2], (L, D, 6 * D), 0.5 * D ** -0.5),
        "ada_b": nrm(ks[3], (L, 6 * D), 0.01),
        "w_in": nrm(ks[4], (L, D, D_IN), D ** -0.5),
        "swa_sink": nrm(ks[5], (L, SWA_HEADS), 0.5),
        "mla_q_norm": gain(ks[6], (L, MLA_Q_RANK)),
        "mla_q_up": nrm(ks[7], (L, MLA_Q_RANK, MLA_HEADS * (MLA_NOPE + MLA_ROPE)), MLA_Q_RANK ** -0.5),
        "mla_kv_norm": gain(ks[8], (L, MLA_KV_RANK)),
        "mla_kv_up": nrm(ks[9], (L, MLA_KV_RANK, MLA_HEADS * (MLA_NOPE + MLA_V)), MLA_KV_RANK ** -0.5),
        "diff_lambda_q1": nrm(ks[10], (L, DIFF_QK), 0.1),
        "diff_lambda_k1": nrm(ks[11], (L, DIFF_QK), 0.1),
        "diff_lambda_q2": nrm(ks[12], (L, DIFF_QK), 0.1),
        "diff_lambda_k2": nrm(ks[13], (L, DIFF_QK), 0.1),
        "diff_subln": gain(ks[14], (L, DIFF_V)),
        "nat_rpb": nrm(ks[15], (L, NAT_HEADS, 2 * NAT_KR_MAX - 1, 2 * NAT_KC - 1), 0.1),
        "w_gate": nrm(ks[16], (L, N_BRANCH, D, D), D ** -0.5),
        "w_branch": nrm(ks[17], (L, N_BRANCH, BRANCH_W, D), DN_BETA * BRANCH_W ** -0.5),
        "w_out": nrm(ks[18], (L, D, D), DN_BETA * D ** -0.5),
        "ln1_g": gain(ks[19], (L, D)),
        "ln1_b": nrm(ks[20], (L, D), 0.02),
        "peer_wq": nrm(ks[21], (L, D, PEER_HEADS * PEER_DKEY), D ** -0.5),
        "peer_keys": nrm(ks[22], (L, PEER_HEADS, 2, PEER_NKEYS, PEER_DKEY // 2), (PEER_DKEY // 2) ** -0.5),
        "peer_u": nrm(ks[23], (L, PEER_EXPERTS, D), D ** -0.5),
        "peer_v": nrm(ks[24], (L, PEER_EXPERTS, D), DN_BETA),
        "ln2_g": gain(ks[25], (L, D)),
        "ln2_b": nrm(ks[26], (L, D), 0.02),
    }


def reference(x, c, ada_w, ada_b, w_in, swa_sink, mla_q_norm, mla_q_up, mla_kv_norm, mla_kv_up,
              diff_lambda_q1, diff_lambda_k1, diff_lambda_q2, diff_lambda_k2, diff_subln, nat_rpb,
              w_gate, w_branch, w_out, ln1_g, ln1_b, peer_wq, peer_keys, peer_u, peer_v, ln2_g, ln2_b):
    b, s, d = x.shape
    cos64, sin64 = rope_tables(s, HEAD_DIM)
    cos32, sin32 = rope_tables(s, MLA_ROPE)
    c_act = jax.nn.silu(c)
    for l in range(DEPTH):
        mod = c_act @ ada_w[l] + ada_b[l]
        sh_mix, sc_mix, g_mix, sh_ffn, sc_ffn, g_ffn = jnp.split(mod, 6, axis=-1)

        u = modulate(x, sh_mix, sc_mix)
        (qa, ka, va, cq, ckv, krope, qc, kc, vc, qd, kd, vd) = jnp.split(u @ w_in[l], IN_SPLITS, axis=-1)
        o_a = swa_attention(qa.reshape(b, s, SWA_HEADS, HEAD_DIM),
                            ka.reshape(b, s, SWA_KV_HEADS, HEAD_DIM),
                            va.reshape(b, s, SWA_KV_HEADS, HEAD_DIM), swa_sink[l], cos64, sin64)
        o_b = mla_attention(cq, ckv, krope, mla_q_norm[l], mla_q_up[l], mla_kv_norm[l], mla_kv_up[l], cos32, sin32)
        lambda_init = 0.8 - 0.6 * math.exp(-0.3 * l)
        o_c = diff_attention(qc, kc, vc, diff_lambda_q1[l], diff_lambda_k1[l], diff_lambda_q2[l],
                             diff_lambda_k2[l], diff_subln[l], lambda_init, cos64, sin64)
        o_d = neighborhood_attention(qd, kd, vd, nat_rpb[l])
        branches = (o_a, o_b, o_c, o_d)
        merged = jnp.zeros_like(x)
        for n in range(N_BRANCH):
            merged = merged + jax.nn.sigmoid(u @ w_gate[l, n]) * (branches[n] @ w_branch[l, n])
        y = merged @ w_out[l]
        x = layer_norm(DN_ALPHA * x + g_mix[:, None, :] * y, ln1_g[l], ln1_b[l])

        u = modulate(x, sh_ffn, sc_ffn)
        y = peer_ffn(u, peer_wq[l], peer_keys[l], peer_u[l], peer_v[l])
        x = layer_norm(DN_ALPHA * x + g_ffn[:, None, :] * y, ln2_g[l], ln2_b[l])
    return x
```

```cpp
#include <hip/hip_runtime.h>
#include <cstdio>
#include <cstdint>
#include <cmath>

namespace pg8 {
#define PG8_LAS __attribute__((address_space(3)))
typedef unsigned short bf16_t;
typedef short bf16x8 __attribute__((ext_vector_type(8)));
typedef float f32x4 __attribute__((ext_vector_type(4)));
typedef unsigned u32x4 __attribute__((ext_vector_type(4)));
constexpr int BM = 256, BK = 64, HALF = 128, HTB = HALF * BK * 2  , STAGE_BYTES = 8 * HTB, NXCD = 8, WGM = 8;

__host__ __device__ __forceinline__ int lds_byte(int r, int c) { const int st = (r >> 4) * 2 + (c >> 5), rr = r & 15, cc = c & 31, ob = rr * 64 + cc * 2; return st * 1024 + (ob ^ (((ob >> 9) & 1) << 5)); }
__host__ __device__ __forceinline__ void stage_rc(int b, int& R, int& C) { const int st = b / 1024, sb = b % 1024, swz = sb ^ (((sb >> 9) & 1) << 5); R = (st >> 1) * 16 + swz / 64; C = (st & 1) * 32 + (swz % 64) / 2; }
__host__ __device__ __forceinline__ int perm32(int rho) { const int n = rho >> 4, i = rho & 15; return 8 * (i >> 2) + 4 * n + (i & 3); }

struct Unit { int pm, pn; };
struct Gemm { const bf16_t* A; const bf16_t* Bt; int M, N, K, lda, ldb; };

struct StaticOrder {
    int nM, nN, nwg, G, c;
    __host__ __device__ void init(int M, int N, int G_, int c_) { nM = M / BM; nN = N / BM; nwg = nM * nN; G = G_; c = c_; }
    __host__ __device__ bool next(int i, Unit& u) const {
        const long L = (long)i * G + c; if (L >= nwg) return false;
        int wgid = (int)L; { const int q = nwg / NXCD, r = nwg % NXCD, xcd = wgid % NXCD, off = wgid / NXCD; wgid = (xcd < r ? xcd * (q + 1) : r * (q + 1) + (xcd - r) * q) + off; }
        const int nig = WGM * nN, gid = wgid / nig, fm = gid * WGM, gsz = (nM - fm) < WGM ? (nM - fm) : WGM;
        u.pm = fm + ((wgid % nig) % gsz); u.pn = (wgid % nig) / gsz; return true;
    }
};

__device__ __forceinline__ unsigned cvt_pk_bf16(float lo, float hi) { unsigned r; asm volatile("v_cvt_pk_bf16_f32 %0, %1, %2" : "=v"(r) : "v"(lo), "v"(hi)); return r; }

template <class Epi, class Sched>
__device__ __forceinline__ void gemm_phase(PG8_LAS unsigned char* lds, const Gemm g, const Sched& S, Epi& E) {
    int tid = threadIdx.x; asm volatile("" : "+v"(tid));
    const int wid = __builtin_amdgcn_readfirstlane(tid >> 6), lane = tid & 63, wr = wid >> 2, wc = wid & 3, fr = lane & 15, fq = lane >> 4;
    const int K = g.K, nt = K / BK;
    unsigned voffA[2], voffB[2];
#pragma unroll
    for (int i = 0; i < 2; ++i) { int R, C; stage_rc(tid * 16 + i * 8192, R, C); const int Rb = (R & ~31) + perm32(R & 31);
        voffA[i] = (unsigned)(R * g.lda + C) * 2u; voffB[i] = (unsigned)(Rb * g.ldb + C) * 2u; }
    const size_t kstep = (size_t)(BK * 2);
    const size_t hstepA = (size_t)HALF * g.lda * 2, hstepB = (size_t)HALF * g.ldb * 2;
    const size_t tstepA = 2 * hstepA, tstepB = 2 * hstepB;
    const unsigned ldsw = (unsigned)wid * 1024u;
    const int aoff = lds_byte(wr * 64 + fr, fq * 8), boff = lds_byte(wc * 32 + fr, fq * 8);
#define PG8_SA(b, h) (((b) * 2 + (h)) * HTB)
#define PG8_SB(b, h) ((4 + (b) * 2 + (h)) * HTB)
#define PG8_STAGE(bufoff, gbase, voff) do { _Pragma("unroll") for (int _i = 0; _i < 2; ++_i) \
        __builtin_amdgcn_global_load_lds((const unsigned*)((const char*)(gbase) + (voff)[_i]), (PG8_LAS unsigned*)(lds + (bufoff) + ldsw + _i * 8192), 16, 0, 0); } while (0)
#define PG8_LDA(dst, b, h) do { _Pragma("unroll") for (int m = 0; m < 4; ++m) _Pragma("unroll") for (int k = 0; k < 2; ++k) dst[m][k] = *(const PG8_LAS bf16x8*)(lds + PG8_SA(b, h) + aoff + m * 2048 + k * 1024); } while (0)
#define PG8_LDB(dst, b, h) do { _Pragma("unroll") for (int n = 0; n < 2; ++n) _Pragma("unroll") for (int k = 0; k < 2; ++k) dst[n][k] = *(const PG8_LAS bf16x8*)(lds + PG8_SB(b, h) + boff + n * 2048 + k * 1024); } while (0)
#define PG8_MMA(ai, bj, At, Bt) do { __builtin_amdgcn_s_setprio(1); _Pragma("unroll") for (int m = 0; m < 4; ++m) _Pragma("unroll") for (int n = 0; n < 2; ++n) _Pragma("unroll") for (int k = 0; k < 2; ++k) \
        acc[ai][bj][m][n] = __builtin_amdgcn_mfma_f32_16x16x32_bf16(Bt[n][k], At[m][k], acc[ai][bj][m][n], 0, 0, 0); __builtin_amdgcn_s_setprio(0); } while (0)
#define PG8_WAIT_V(n) asm volatile("s_waitcnt vmcnt(" #n ")" ::: "memory")
#define PG8_WAIT_L(n) asm volatile("s_waitcnt lgkmcnt(" #n ")" ::: "memory")
#define PG8_BAR __builtin_amdgcn_s_barrier()
#define PG8_SCHED __builtin_amdgcn_sched_barrier(0)
    Unit cur, nxt; int ui = 0;
    if (!S.next(0, cur)) return;
    f32x4 acc[2][2][4][2];
#pragma unroll
    for (int a = 0; a < 2; ++a)
#pragma unroll
        for (int b = 0; b < 2; ++b)
#pragma unroll
            for (int m = 0; m < 4; ++m)
#pragma unroll
                for (int n = 0; n < 2; ++n) acc[a][b][m][n] = (f32x4){0.f, 0.f, 0.f, 0.f};
    bf16x8 At[4][2], B0[2][2], B1[2][2];
    const char* cA = (const char*)g.A + (size_t)cur.pm * tstepA; const char* cB = (const char*)g.Bt + (size_t)cur.pn * tstepB;
    PG8_STAGE(PG8_SB(0, 0), cB, voffB); PG8_STAGE(PG8_SB(0, 1), cB + hstepB, voffB); PG8_STAGE(PG8_SA(0, 0), cA, voffA); PG8_STAGE(PG8_SA(0, 1), cA + hstepA, voffA);
    if (wr == 1) PG8_BAR;
    PG8_WAIT_V(2); PG8_BAR;
    PG8_STAGE(PG8_SB(1, 0), cB + kstep, voffB); PG8_STAGE(PG8_SA(1, 0), cA + kstep, voffA); PG8_STAGE(PG8_SB(1, 1), cB + hstepB + kstep, voffB);
    PG8_WAIT_V(6); PG8_BAR;
    for (;;) {
        const bool has_next = S.next(ui + 1, nxt);
        const char* nA = has_next ? (const char*)g.A + (size_t)nxt.pm * tstepA : cA; const char* nB = has_next ? (const char*)g.Bt + (size_t)nxt.pn * tstepB : cB;
#pragma unroll 1
        for (int t = 0; t < nt; t += 2) {
            const bool last = (t == nt - 2);
            const char* a1 = cA + (size_t)(t + 1) * kstep;
            const char* a2 = last ? nA : cA + (size_t)(t + 2) * kstep; const char* b2 = last ? nB : cB + (size_t)(t + 2) * kstep;
            const char* a3 = a2 + kstep; const char* b3 = b2 + kstep;
            PG8_LDB(B0, 0, 0); PG8_LDB(B1, 0, 1); PG8_SCHED; PG8_LDA(At, 0, 0); PG8_STAGE(PG8_SA(1, 1), a1 + hstepA, voffA);
            PG8_WAIT_V(8); PG8_WAIT_L(0); PG8_BAR; PG8_MMA(0, 0, At, B0); PG8_MMA(0, 1, At, B1); PG8_BAR; PG8_SCHED;
            PG8_LDA(At, 0, 1); PG8_STAGE(PG8_SB(0, 0), b2, voffB); PG8_STAGE(PG8_SB(0, 1), b2 + hstepB, voffB); PG8_STAGE(PG8_SA(0, 0), a2, voffA);
            PG8_WAIT_V(8); PG8_WAIT_L(0); PG8_BAR; PG8_MMA(1, 0, At, B0); PG8_MMA(1, 1, At, B1); PG8_BAR; PG8_SCHED;
            PG8_LDB(B0, 1, 0); PG8_LDB(B1, 1, 1); PG8_SCHED; PG8_LDA(At, 1, 0); PG8_STAGE(PG8_SA(0, 1), a2 + hstepA, voffA);
            PG8_WAIT_V(8); PG8_WAIT_L(0); PG8_BAR; PG8_MMA(0, 0, At, B0); PG8_MMA(0, 1, At, B1); PG8_BAR; PG8_SCHED;
            PG8_LDA(At, 1, 1); PG8_STAGE(PG8_SB(1, 0), b3, voffB); PG8_STAGE(PG8_SB(1, 1), b3 + hstepB, voffB); PG8_STAGE(PG8_SA(1, 0), a3, voffA);
            PG8_WAIT_V(8); PG8_WAIT_L(0); PG8_BAR; PG8_MMA(1, 0, At, B0); PG8_MMA(1, 1, At, B1); PG8_BAR; PG8_SCHED;
        }
        if (wr == 0) PG8_BAR;
        E(acc, cur, wr, wc, fr, fq);
        if (!has_next) break;
#pragma unroll
        for (int a = 0; a < 2; ++a)
#pragma unroll
            for (int b = 0; b < 2; ++b)
#pragma unroll
                for (int m = 0; m < 4; ++m)
#pragma unroll
                    for (int n = 0; n < 2; ++n) acc[a][b][m][n] = (f32x4){0.f, 0.f, 0.f, 0.f};
        cur = nxt; cA = nA; cB = nB; ++ui;
        if (wr == 1) PG8_BAR;
    }
    PG8_WAIT_V(0);
    PG8_BAR;
#undef PG8_SA
#undef PG8_SB
#undef PG8_STAGE
#undef PG8_LDA
#undef PG8_LDB
#undef PG8_MMA
#undef PG8_WAIT_V
#undef PG8_WAIT_L
#undef PG8_BAR
#undef PG8_SCHED
}
}

constexpr int BATCH = 4, SEQ = 8192, T = BATCH * SEQ, DM = 1024, DEPTH = 2;
constexpr int NWAVES = 8, NTHR = 512;
constexpr float LN_EPS = 1e-5f;
constexpr float DN_ALPHA = 1.4142135623730951f;
constexpr float LOG2E = 1.4426950408889634f;
constexpr int D_IN = 4512, NIN = 4608;
constexpr float C_D64 = 0.125f * LOG2E;
constexpr float C_MLA = 0.10206207261596577f * LOG2E;
constexpr int NPHASE = 1 + 11 * DEPTH;

constexpr size_t MiB = 1u << 20;
constexpr size_t WS_CTL = 0, CTL_ZERO_BYTES = 1 * MiB;
constexpr size_t WS_MOD = 1 * MiB;
constexpr size_t WS_ROPE64 = 2 * MiB;
constexpr size_t WS_ROPE32 = 4 * MiB;
constexpr size_t WS_RSTD = 5 * MiB;
constexpr size_t WS_WIN = 6 * MiB;
constexpr size_t WS_WG = 15 * MiB;
constexpr size_t WS_WB = 23 * MiB;
constexpr size_t WS_WO = 27 * MiB;
constexpr size_t WS_WQ = 29 * MiB;
constexpr size_t WS_QUP = 33 * MiB;
constexpr size_t WS_KVUP = 34 * MiB;
constexpr size_t WS_KEYS = 35 * MiB;
constexpr size_t WS_U = 36 * MiB;
constexpr size_t WS_SWAQ = 100 * MiB;
constexpr size_t WS_SWAKV = 132 * MiB;
constexpr size_t WS_LAT = 148 * MiB;
constexpr size_t WS_DIFQ = 196 * MiB;
constexpr size_t WS_DIFK = 228 * MiB;
constexpr size_t WS_DIFV = 260 * MiB;
constexpr size_t WS_NATQ = 292 * MiB;
constexpr size_t WS_NATK = 324 * MiB;
constexpr size_t WS_NATV = 356 * MiB;
constexpr size_t WS_MQN = 388 * MiB;
constexpr size_t WS_MQR = 420 * MiB;
constexpr size_t WS_KVB = 436 * MiB;
constexpr size_t WS_DSCR = 500 * MiB;
constexpr size_t WS_END = 516 * MiB;
constexpr size_t WS_SG = WS_NATK;
constexpr size_t WS_MERGED = WS_DIFK;
constexpr size_t WS_QP = WS_SWAQ;
constexpr size_t WS_PIDX = WS_NATQ;
constexpr size_t WS_PGATE = WS_NATQ + 16 * MiB;
constexpr size_t WS_UTAB = WS_KVB;
constexpr size_t WS_VTAB = WS_KVB + 32 * MiB;
constexpr int CW_BAR = 4096;

constexpr int RING_BYTES = 131072;
constexpr int LDSCTL_OFF = RING_BYTES, MISC_OFF = LDSCTL_OFF + 320;
constexpr int LDS_BYTES = 147456;
#define GAS __attribute__((address_space(1)))
#define LAS __attribute__((address_space(3)))
typedef unsigned short bf16;
typedef unsigned v4u __attribute__((ext_vector_type(4)));
typedef float f32x4 __attribute__((ext_vector_type(4)));
typedef short bf16x8 __attribute__((ext_vector_type(8)));
typedef GAS unsigned gu32;
typedef GAS unsigned long long gu64;
#define RLX_AGENT __ATOMIC_RELAXED, __HIP_MEMORY_SCOPE_AGENT
#define LDS_WAIT() asm volatile("s_waitcnt lgkmcnt(0)" ::: "memory")
#define VM_WAIT() asm volatile("s_waitcnt vmcnt(0)" ::: "memory")
__device__ __forceinline__ unsigned long long rt() { return __builtin_amdgcn_s_memrealtime(); }
__device__ __forceinline__ unsigned f2bf(float f) { unsigned u = __builtin_bit_cast(unsigned, f); return (u + 0x7fffu + ((u >> 16) & 1u)) >> 16; }
__device__ __forceinline__ unsigned pk2(float lo, float hi) { return f2bf(lo) | (f2bf(hi) << 16); }

#define XB_TMO      128
#define XB_XCNT(j)  (256  + 64 * (j))
#define XB_XSUB(j)  (1280 + 64 * (j))
#define XB_XGEN(j)  (2304 + 64 * (j))
#define XB_TOP      3328
#define XB_TOPGEN   3392
#define XCD_BAR_WORDS 3456
#define XB_SPIN_CAP (1u << 18)

__device__ __forceinline__ unsigned xb_ld(unsigned* p)              { return __hip_atomic_load(p, __ATOMIC_RELAXED, __HIP_MEMORY_SCOPE_AGENT); }
__device__ __forceinline__ unsigned xb_add(unsigned* p, unsigned v) { return __hip_atomic_fetch_add(p, v, __ATOMIC_RELAXED, __HIP_MEMORY_SCOPE_AGENT); }
__device__ __forceinline__ unsigned xb_xcc_id() { return (unsigned)__builtin_amdgcn_s_getreg((3 << 11) | 20) & 0xFu; }
#define XB_SPIN(cond, bar) do { unsigned _sp = 0; while (cond) { __builtin_amdgcn_s_sleep(1); \
    if ((++_sp & 255u) == 0u) { if (xb_ld(&(bar)[XB_TMO])) break; if (_sp > XB_SPIN_CAP) { atomicAdd(&(bar)[XB_TMO], 1u); break; } } } } while (0)

struct XcdBarrier {
    unsigned* bar; unsigned x;
    volatile LAS unsigned* st;
};

__device__ __forceinline__ XcdBarrier xcd_barrier_post(unsigned* bar, volatile LAS unsigned* st) {
    XcdBarrier b; b.bar = bar; b.x = xb_xcc_id(); b.st = st;
    if (threadIdx.x == 0) (void)xb_add(&bar[XB_XCNT(b.x)], 1u);
    return b;
}
__device__ __forceinline__ void xcd_barrier_complete(unsigned* bar, unsigned x, unsigned& nloc, unsigned& nx) {
    const unsigned G = gridDim.x * gridDim.y * gridDim.z;
    unsigned sum, cnt, mine, sp = 0u;
    for (;;) {
        sum = 0u; cnt = 0u; mine = 0u;
#pragma unroll
        for (unsigned j = 0; j < 16; ++j) { const unsigned c = xb_ld(&bar[XB_XCNT(j)]); sum += c; cnt += (c > 0u) ? 1u : 0u; mine = (j == x) ? c : mine; }
        if (sum == G) break;
        __builtin_amdgcn_s_sleep(1);
        if ((++sp & 255u) == 0u) { if (xb_ld(&bar[XB_TMO])) break; if (sp > XB_SPIN_CAP) { atomicAdd(&bar[XB_TMO], 1u); break; } }
    }
    nloc = mine > 0u ? mine : 1u; nx = cnt > 0u ? cnt : 1u;
}

__device__ __forceinline__ void xcd_barrier(const XcdBarrier& b) {
    asm volatile("s_waitcnt vmcnt(0)" ::: "memory");
    __syncthreads();
    if (threadIdx.x == 0) {
        unsigned* bar = b.bar;
        __builtin_amdgcn_s_waitcnt(0);
        unsigned nloc = b.st[0], nx = b.st[1];
        if (nloc == 0u) { xcd_barrier_complete(bar, b.x, nloc, nx); b.st[0] = nloc; b.st[1] = nx; }
        const unsigned old = xb_add(&bar[XB_XSUB(b.x)], 1u);
        const unsigned gen = old / nloc;
        if (old + 1u == (gen + 1u) * nloc) {
            __builtin_amdgcn_fence(__ATOMIC_RELEASE, "agent");
            asm volatile("s_waitcnt vmcnt(0)" ::: "memory");
            const unsigned og = xb_add(&bar[XB_TOP], 1u);
            const unsigned tg = og / nx;
            if (og + 1u == (tg + 1u) * nx) xb_add(&bar[XB_TOPGEN], 1u);
            else XB_SPIN(xb_ld(&bar[XB_TOPGEN]) == tg, bar);
            __builtin_amdgcn_fence(__ATOMIC_ACQUIRE, "agent");
            xb_add(&bar[XB_XGEN(b.x)], 1u);
            asm volatile("s_waitcnt vmcnt(0)" ::: "memory");
        } else {
            XB_SPIN(xb_ld(&bar[XB_XGEN(b.x)]) == gen, bar);
            __builtin_amdgcn_fence(__ATOMIC_ACQUIRE, "agent");
            asm volatile("s_waitcnt vmcnt(0)" ::: "memory");
        }
    }
    __syncthreads();
}

typedef float f32x16 __attribute__((ext_vector_type(16)));
typedef float f32x2 __attribute__((ext_vector_type(2)));
typedef short s16x4 __attribute__((ext_vector_type(4)));
typedef __bf16 bf16x2_t __attribute__((ext_vector_type(2)));

__device__ __forceinline__ float wave_sum(float v) {
#pragma unroll
    for (int o = 1; o < 64; o <<= 1) v += __shfl_xor(v, o);
    return v;
}
__device__ __forceinline__ float bf_lo(unsigned u) { return __builtin_bit_cast(float, u << 16); }
__device__ __forceinline__ float bf_hi(unsigned u) { return __builtin_bit_cast(float, u & 0xffff0000u); }
__device__ __forceinline__ unsigned cvtpk(float lo, float hi) { f32x2 v = {lo, hi}; bf16x2_t b = __builtin_convertvector(v, bf16x2_t); return __builtin_bit_cast(unsigned, b); }
__device__ __forceinline__ float fast_exp2(float x) { return __builtin_amdgcn_exp2f(x); }
__device__ __forceinline__ float fast_rcp(float x) { return __builtin_amdgcn_rcpf(x); }
__device__ __forceinline__ float halves_max(float m) { auto rr = __builtin_amdgcn_permlane32_swap(__float_as_uint(m), __float_as_uint(m), false, false); return fmaxf(__uint_as_float(rr[0]), __uint_as_float(rr[1])); }
__device__ __forceinline__ float halves_sum(float m) { auto rr = __builtin_amdgcn_permlane32_swap(__float_as_uint(m), __float_as_uint(m), false, false); return __uint_as_float(rr[0]) + __uint_as_float(rr[1]); }
__device__ __forceinline__ unsigned halves_umax(unsigned m) { auto rr = __builtin_amdgcn_permlane32_swap(m, m, false, false); return rr[0] > rr[1] ? rr[0] : rr[1]; }

__device__ __forceinline__ int rope64_src(int j) { return (j & 1) ? (j >> 1) + 32 : (j >> 1); }
__device__ __forceinline__ int rope32_src(int j) { return (j & 1) ? (j >> 1) + 16 : (j >> 1); }
struct MapId { __device__ __forceinline__ int operator()(int n) const { return n; } };
struct MapIn { __device__ __forceinline__ int operator()(int n) const {
    if (n < 640) return (n & ~63) + rope64_src(n & 63);
    if (n < 768) return n;
    if (n < 1536) { const int m = n - 768; if (m < 640) return 768 + m; if (m < 672) return 1408 + rope32_src(m - 640); return -1; }
    if (n < 2560) { const int m = n - 1536; return 1440 + (m & ~63) + rope64_src(m & 63); }
    return 2464 + (n - 2560);
} };
struct MapQup { __device__ __forceinline__ int operator()(int n) const { if (n < 512) return (n >> 6) * 96 + (n & 63); const int m = n - 512; return (m >> 5) * 96 + 64 + rope32_src(m & 31); } };
struct MapKvup { __device__ __forceinline__ int operator()(int n) const { if (n < 512) return (n >> 6) * 128 + (n & 63); const int m = n - 512; return (m >> 6) * 128 + 64 + (m & 63); } };

template <class Map>
__device__ __forceinline__ void conv_item(const float* __restrict__ W, int ldw, const float* __restrict__ kscale, int K, bf16* WT, int n0, int k0, const Map& map, LAS float* scr, int lane) {
    const int nn = lane & 31; const int src = map(n0 + nn);
#pragma unroll 8
    for (int i = 0; i < 32; ++i) { const int kk = 2 * i + (lane >> 5);
        float v = (src >= 0) ? W[(size_t)(k0 + kk) * ldw + src] : 0.f;
        if (kscale) v *= kscale[k0 + kk];
        scr[kk * 33 + nn] = v; }
    LDS_WAIT(); asm volatile("" ::: "memory");
    const int c = lane & 7;
#pragma unroll
    for (int j = 0; j < 4; ++j) { const int n = (lane >> 3) + 8 * j; const LAS float* s = scr + (8 * c) * 33 + n;
        v4u o; o.x = pk2(s[0 * 33], s[1 * 33]); o.y = pk2(s[2 * 33], s[3 * 33]); o.z = pk2(s[4 * 33], s[5 * 33]); o.w = pk2(s[6 * 33], s[7 * 33]);
        *(GAS v4u*)(WT + (size_t)(n0 + n) * K + k0 + 8 * c) = o; }
    LDS_WAIT(); asm volatile("" ::: "memory");
}

struct Ptrs {
    const float* in[27]; float* out; unsigned char* ws;
};

__device__ __forceinline__ void convert_weights(const Ptrs& P, int l, LAS unsigned char* lds, int gw, int NGW, int wave, int lane) {
    LAS float* scr = (LAS float*)(lds + wave * 16384);
    unsigned char* ws = P.ws;
    constexpr int I_IN = 16 * 144, I_G = 16 * 32, I_B = 8 * 32, I_O = 16 * 32, I_Q = 16 * 64, I_QU = 6 * 24, I_KU = 4 * 32;
    constexpr int NIT = I_IN + 4 * I_G + 4 * I_B + I_O + I_Q + I_QU + I_KU;
    for (int it = gw; it < NIT; it += NGW) {
        int r = it;
        if (r < I_IN) { conv_item(P.in[4] + (size_t)l * 1024 * D_IN, D_IN, nullptr, 1024, (bf16*)(ws + WS_WIN), 32 * (r % 144), 64 * (r / 144), MapIn(), scr, lane); continue; } r -= I_IN;
        if (r < 4 * I_G) { const int n = r / I_G, q = r % I_G; conv_item(P.in[16] + ((size_t)l * 4 + n) * 1024 * 1024, 1024, nullptr, 1024, (bf16*)(ws + WS_WG) + (size_t)n * 1024 * 1024, 32 * (q % 32), 64 * (q / 32), MapId(), scr, lane); continue; } r -= 4 * I_G;
        if (r < 4 * I_B) { const int n = r / I_B, q = r % I_B; conv_item(P.in[17] + ((size_t)l * 4 + n) * 512 * 1024, 1024, nullptr, 512, (bf16*)(ws + WS_WB) + (size_t)n * 1024 * 512, 32 * (q % 32), 64 * (q / 32), MapId(), scr, lane); continue; } r -= 4 * I_B;
        if (r < I_O) { conv_item(P.in[18] + (size_t)l * 1024 * 1024, 1024, nullptr, 1024, (bf16*)(ws + WS_WO), 32 * (r % 32), 64 * (r / 32), MapId(), scr, lane); continue; } r -= I_O;
        if (r < I_Q) { conv_item(P.in[21] + (size_t)l * 1024 * 2048, 2048, nullptr, 1024, (bf16*)(ws + WS_WQ), 32 * (r % 64), 64 * (r / 64), MapId(), scr, lane); continue; } r -= I_Q;
        if (r < I_QU) { conv_item(P.in[7] + (size_t)l * 384 * 768, 768, P.in[6] + l * 384, 384, (bf16*)(ws + WS_QUP), 32 * (r % 24), 64 * (r / 24), MapQup(), scr, lane); continue; } r -= I_QU;
        conv_item(P.in[9] + (size_t)l * 256 * 1024, 1024, P.in[8] + l * 256, 256, (bf16*)(ws + WS_KVUP), 32 * (r % 32), 64 * (r / 32), MapKvup(), scr, lane);
    }
    const float* ks = P.in[22] + (size_t)l * 262144; bf16* kd = (bf16*)(ws + WS_KEYS);
    for (int i = gw * 64 + lane; i < 262144 / 8; i += NGW * 64) {
        const f32x4 a = *(const GAS f32x4*)(ks + 8 * i), b = *(const GAS f32x4*)(ks + 8 * i + 4);
        v4u o; o.x = pk2(a.x, a.y); o.y = pk2(a.z, a.w); o.z = pk2(b.x, b.y); o.w = pk2(b.z, b.w);
        *(GAS v4u*)(kd + 8 * i) = o; }
}

__device__ __forceinline__ void compute_mod(const Ptrs& P, LAS unsigned char* lds, int tid) {
    LAS float* sc = (LAS float*)lds; LAS float* red = (LAS float*)(lds + 16384);
    for (int i = tid; i < 4096; i += NTHR) { const float c = P.in[1][i]; sc[i] = c / (1.f + __expf(-c)); }
    __syncthreads();
    float* mod = (float*)(P.ws + WS_MOD);
    for (int item = blockIdx.x; item < 96; item += gridDim.x) {
        const int l = item / 48, cb = item % 48, cl = tid & 127, kg = tid >> 7, col = cb * 128 + cl;
        const float* w = P.in[2] + ((size_t)l * 1024 + kg * 256) * 6144 + col;
        float a0 = 0.f, a1 = 0.f, a2 = 0.f, a3 = 0.f;
#pragma unroll 16
        for (int k = 0; k < 256; ++k) { const float wv = w[(size_t)k * 6144]; const int kk = kg * 256 + k;
            a0 += sc[kk] * wv; a1 += sc[1024 + kk] * wv; a2 += sc[2048 + kk] * wv; a3 += sc[3072 + kk] * wv; }
        red[(kg * 4 + 0) * 128 + cl] = a0; red[(kg * 4 + 1) * 128 + cl] = a1; red[(kg * 4 + 2) * 128 + cl] = a2; red[(kg * 4 + 3) * 128 + cl] = a3;
        __syncthreads();
        { const int b = tid >> 7; const float s = red[(0 * 4 + b) * 128 + cl] + red[(1 * 4 + b) * 128 + cl] + red[(2 * 4 + b) * 128 + cl] + red[(3 * 4 + b) * 128 + cl];
          mod[((size_t)l * 4 + b) * 6144 + col] = s + P.in[3][l * 6144 + col]; }
        __syncthreads();
    }
}

__device__ __forceinline__ void compute_rope(const Ptrs& P, const float* inv64, const float* inv32, int gtid, int nthr) {
    f32x2* r64 = (f32x2*)(P.ws + WS_ROPE64); f32x2* r32 = (f32x2*)(P.ws + WS_ROPE32);
    for (int i = gtid; i < SEQ * 48; i += nthr) {
        const bool big = i < SEQ * 32; const int j = big ? i : i - SEQ * 32; const int pos = big ? (j >> 5) : (j >> 4); const int f = big ? (j & 31) : (j & 15);
        const float ang = (float)pos * (big ? inv64[f] : inv32[f]);
        double tr = (double)ang * 0.15915494309189535; tr -= rint(tr); const float fr = (float)tr;
        f32x2 cs; cs.x = __builtin_amdgcn_cosf(fr); cs.y = __builtin_amdgcn_sinf(fr);
        if (big) r64[j] = cs; else r32[j] = cs; }
}

__device__ __forceinline__ void ln_mod_row(const float* xrow, const float* sh, const float* sc, bf16* orow, int lane) {
    const GAS f32x4* xr = (const GAS f32x4*)xrow + lane;
    f32x4 v[4]; float s = 0.f;
#pragma unroll
    for (int j = 0; j < 4; ++j) { v[j] = xr[64 * j]; s += (v[j].x + v[j].y) + (v[j].z + v[j].w); }
    const float mean = wave_sum(s) * (1.f / DM); float s2 = 0.f;
#pragma unroll
    for (int j = 0; j < 4; ++j) { v[j] = v[j] - mean; s2 += (v[j].x * v[j].x + v[j].y * v[j].y) + (v[j].z * v[j].z + v[j].w * v[j].w); }
    const float rstd = 1.f / sqrtf(wave_sum(s2) * (1.f / DM) + LN_EPS);
    GAS unsigned long long* o8 = (GAS unsigned long long*)orow + lane;
#pragma unroll
    for (int j = 0; j < 4; ++j) { const f32x4 a = ((const GAS f32x4*)sc)[lane + 64 * j], b = ((const GAS f32x4*)sh)[lane + 64 * j];
        const f32x4 y = v[j] * rstd * (a + 1.f) + b;
        o8[64 * j] = (unsigned long long)pk2(y.x, y.y) | ((unsigned long long)pk2(y.z, y.w) << 32); }
}

#define EPI_ROWS_BEGIN \
    _Pragma("unroll") for (int ai = 0; ai < 2; ++ai) _Pragma("unroll") for (int m = 0; m < 4; ++m) { const int row = u.pm * 256 + ai * 128 + wr * 64 + m * 16 + fr;
#define EPI_ROWS_END }
__device__ __forceinline__ void store8(bf16* p, const float (&x)[8]) { v4u w; w.x = cvtpk(x[0], x[1]); w.y = cvtpk(x[2], x[3]); w.z = cvtpk(x[4], x[5]); w.w = cvtpk(x[6], x[7]); *(GAS v4u*)p = w; }
__device__ __forceinline__ void rope4(float (&x)[8], const f32x2* tab) {
    const f32x4 t0 = *(const GAS f32x4*)tab, t1 = *(const GAS f32x4*)(tab + 2);
    const float c[4] = {t0.x, t0.z, t1.x, t1.z}, s[4] = {t0.y, t0.w, t1.y, t1.w};
#pragma unroll
    for (int k = 0; k < 4; ++k) { const float a = x[2 * k], b = x[2 * k + 1]; x[2 * k] = a * c[k] - b * s[k]; x[2 * k + 1] = a * s[k] + b * c[k]; }
}

struct EpiInProj {
    unsigned char* ws;
    __device__ __forceinline__ void operator()(const pg8::f32x4 (&acc)[2][2][4][2], const pg8::Unit& u, int wr, int wc, int fr, int fq) {
        const int pn = u.pn; size_t boff; int pitch, lc0, mode0, mode1;
        if (pn < 2) { boff = WS_SWAQ; pitch = 512; lc0 = pn * 256; mode0 = mode1 = 2; }
        else if (pn == 2) { boff = WS_SWAKV; pitch = 256; lc0 = 0; mode0 = 1; mode1 = 0; }
        else if (pn < 6) { boff = WS_LAT; pitch = 768; lc0 = (pn - 3) * 256; mode0 = 0; mode1 = (pn == 5) ? 4 : 0; }
        else { const int q = (pn - 6) >> 1; boff = WS_DIFQ + (size_t)q * 32 * MiB; pitch = 512; lc0 = ((pn - 6) & 1) * 256; mode0 = mode1 = (q == 0) ? 2 : (q == 1) ? 1 : (q == 3) ? 3 : 0; }
        bf16* base = (bf16*)(ws + boff);
        const f32x2* r64 = (const f32x2*)(ws + WS_ROPE64); const f32x2* r32 = (const f32x2*)(ws + WS_ROPE32);
        EPI_ROWS_BEGIN
            const int pos = row & (SEQ - 1);
#pragma unroll
            for (int bj = 0; bj < 2; ++bj) {
                const int mode = bj ? mode1 : mode0; const int lcol = lc0 + bj * 128 + wc * 32 + fq * 8;
                float x[8] = {acc[ai][bj][m][0][0], acc[ai][bj][m][0][1], acc[ai][bj][m][0][2], acc[ai][bj][m][0][3], acc[ai][bj][m][1][0], acc[ai][bj][m][1][1], acc[ai][bj][m][1][2], acc[ai][bj][m][1][3]};
                if (mode == 1 || mode == 2) rope4(x, r64 + pos * 32 + ((lcol & 63) >> 1));
                if (mode == 4 && lcol >= 640 && lcol < 672) rope4(x, r32 + pos * 16 + ((lcol - 640) >> 1));
                if (mode == 2 || mode == 3) {
#pragma unroll
                    for (int k = 0; k < 8; ++k) x[k] *= C_D64; }
                store8(base + (size_t)row * pitch + lcol, x);
            }
        EPI_ROWS_END
    }
};
struct EpiQup {
    unsigned char* ws;
    __device__ __forceinline__ void operator()(const pg8::f32x4 (&acc)[2][2][4][2], const pg8::Unit& u, int wr, int wc, int fr, int fq) {
        const int pn = u.pn; const float* rstd = (const float*)(ws + WS_RSTD);
        bf16* base = (bf16*)(ws + (pn < 2 ? WS_MQN : WS_MQR)); const int pitch = pn < 2 ? 512 : 256, lc0 = pn < 2 ? pn * 256 : 0;
        EPI_ROWS_BEGIN
            const float sc = rstd[2 * row] * C_MLA;
#pragma unroll
            for (int bj = 0; bj < 2; ++bj) {
                const int lcol = lc0 + bj * 128 + wc * 32 + fq * 8;
                float x[8] = {acc[ai][bj][m][0][0], acc[ai][bj][m][0][1], acc[ai][bj][m][0][2], acc[ai][bj][m][0][3], acc[ai][bj][m][1][0], acc[ai][bj][m][1][1], acc[ai][bj][m][1][2], acc[ai][bj][m][1][3]};
#pragma unroll
                for (int k = 0; k < 8; ++k) x[k] *= sc;
                store8(base + (size_t)row * pitch + lcol, x);
            }
        EPI_ROWS_END
    }
};
struct EpiScaleRow {
    bf16* O; int ldc; const float* rowscale; int rs_stride;
    __device__ __forceinline__ void operator()(const pg8::f32x4 (&acc)[2][2][4][2], const pg8::Unit& u, int wr, int wc, int fr, int fq) {
        EPI_ROWS_BEGIN
            const float sc = rowscale ? rowscale[(size_t)row * rs_stride] : 1.f;
#pragma unroll
            for (int bj = 0; bj < 2; ++bj) {
                const int col = u.pn * 256 + bj * 128 + wc * 32 + fq * 8;
                float x[8] = {acc[ai][bj][m][0][0], acc[ai][bj][m][0][1], acc[ai][bj][m][0][2], acc[ai][bj][m][0][3], acc[ai][bj][m][1][0], acc[ai][bj][m][1][1], acc[ai][bj][m][1][2], acc[ai][bj][m][1][3]};
#pragma unroll
                for (int k = 0; k < 8; ++k) x[k] *= sc;
                store8(O + (size_t)row * ldc + col, x);
            }
        EPI_ROWS_END
    }
};
struct EpiSigmoid {
    bf16* O;
    __device__ __forceinline__ void operator()(const pg8::f32x4 (&acc)[2][2][4][2], const pg8::Unit& u, int wr, int wc, int fr, int fq) {
        EPI_ROWS_BEGIN
#pragma unroll
            for (int bj = 0; bj < 2; ++bj) {
                const int col = u.pn * 256 + bj * 128 + wc * 32 + fq * 8;
                float x[8] = {acc[ai][bj][m][0][0], acc[ai][bj][m][0][1], acc[ai][bj][m][0][2], acc[ai][bj][m][0][3], acc[ai][bj][m][1][0], acc[ai][bj][m][1][1], acc[ai][bj][m][1][2], acc[ai][bj][m][1][3]};
#pragma unroll
                for (int k = 0; k < 8; ++k) x[k] = fast_rcp(1.f + fast_exp2(-LOG2E * x[k]));
                store8(O + (size_t)row * 1024 + col, x);
            }
        EPI_ROWS_END
    }
};
struct EpiGated {
    const bf16* G; bf16* Mg; int accumulate;
    __device__ __forceinline__ void operator()(const pg8::f32x4 (&acc)[2][2][4][2], const pg8::Unit& u, int wr, int wc, int fr, int fq) {
        EPI_ROWS_BEGIN
#pragma unroll
            for (int bj = 0; bj < 2; ++bj) {
                const int col = u.pn * 256 + bj * 128 + wc * 32 + fq * 8; const size_t off = (size_t)row * 1024 + col;
                float x[8] = {acc[ai][bj][m][0][0], acc[ai][bj][m][0][1], acc[ai][bj][m][0][2], acc[ai][bj][m][0][3], acc[ai][bj][m][1][0], acc[ai][bj][m][1][1], acc[ai][bj][m][1][2], acc[ai][bj][m][1][3]};
                const v4u g = *(const GAS v4u*)(G + off);
                x[0] *= bf_lo(g.x); x[1] *= bf_hi(g.x); x[2] *= bf_lo(g.y); x[3] *= bf_hi(g.y); x[4] *= bf_lo(g.z); x[5] *= bf_hi(g.z); x[6] *= bf_lo(g.w); x[7] *= bf_hi(g.w);
                if (accumulate) { const v4u o = *(const GAS v4u*)(Mg + off);
                    x[0] += bf_lo(o.x); x[1] += bf_hi(o.x); x[2] += bf_lo(o.y); x[3] += bf_hi(o.y); x[4] += bf_lo(o.z); x[5] += bf_hi(o.z); x[6] += bf_lo(o.w); x[7] += bf_hi(o.w); }
                store8(Mg + off, x);
            }
        EPI_ROWS_END
    }
};
struct EpiResid {
    const float* X; float* Z; const float* gate;
    __device__ __forceinline__ void operator()(const pg8::f32x4 (&acc)[2][2][4][2], const pg8::Unit& u, int wr, int wc, int fr, int fq) {
        EPI_ROWS_BEGIN
            const float* gb = gate + (size_t)(row / SEQ) * 6144;
#pragma unroll
            for (int bj = 0; bj < 2; ++bj) {
                const int col = u.pn * 256 + bj * 128 + wc * 32 + fq * 8; const size_t off = (size_t)row * 1024 + col;
#pragma unroll
                for (int n = 0; n < 2; ++n) { const f32x4 xv = *(const GAS f32x4*)(X + off + 4 * n), gv = *(const GAS f32x4*)(gb + col + 4 * n);
                    f32x4 a; a.x = acc[ai][bj][m][n][0]; a.y = acc[ai][bj][m][n][1]; a.z = acc[ai][bj][m][n][2]; a.w = acc[ai][bj][m][n][3];
#ifdef DBG_NO_MIX
                    a = a * 0.f;
#endif
                    *(GAS f32x4*)(Z + off + 4 * n) = xv * DN_ALPHA + gv * a; }
            }
        EPI_ROWS_END
    }
};

__device__ __forceinline__ int crow(int r, int hi) { return (r & 3) + 8 * (r >> 2) + 4 * hi; }
__device__ __forceinline__ s16x4 vtr(const LAS unsigned char* p) { typedef short v4i16_t __attribute__((ext_vector_type(4))); return __builtin_bit_cast(s16x4, __builtin_amdgcn_ds_read_tr16_b64_v4i16((LAS v4i16_t*)p)); }

template <class P>
__device__ __forceinline__ void flash_run(const P& pol, LAS unsigned char* lds, const bf16x8 (&qf)[P::DQK / 16], f32x16 (&o)[P::DV / 32], float& m_io, float& l_io) {
    constexpr int DQK = P::DQK, DV = P::DV, KSTRB = DQK * 2 + 16, KB = 64 * KSTRB, VB = 64 * DV * 2, NDB = DV / 32, KCH = DQK / 8, VCH = DV / 8;
    constexpr int NKC = 64 * KCH, NVC = 64 * VCH, KPT = (NKC + NTHR - 1) / NTHR, VPT = (NVC + NTHR - 1) / NTHR;
    int tid = threadIdx.x; asm volatile("" : "+v"(tid)); const int lane = tid & 63, r32 = lane & 31, hi = lane >> 5;
    const int nt = pol.ntiles;
    v4u kreg[KPT], vreg[VPT];
#define FL_LOAD(t) do { \
        _Pragma("unroll") for (int i_ = 0; i_ < KPT; ++i_) { const int id_ = tid + NTHR * i_; if (NKC % NTHR == 0 || id_ < NKC) kreg[i_] = *(const GAS v4u*)pol.kptr((t), id_ / KCH, id_ % KCH); } \
        _Pragma("unroll") for (int i_ = 0; i_ < VPT; ++i_) { const int id_ = tid + NTHR * i_; if (NVC % NTHR == 0 || id_ < NVC) vreg[i_] = *(const GAS v4u*)pol.vptr((t), id_ / VCH, id_ % VCH); } } while (0)
#define FL_STORE(buf) do { \
        _Pragma("unroll") for (int i_ = 0; i_ < KPT; ++i_) { const int id_ = tid + NTHR * i_; if (NKC % NTHR == 0 || id_ < NKC) *(LAS v4u*)(lds + (buf) * KB + (id_ / KCH) * KSTRB + (id_ % KCH) * 16) = kreg[i_]; } \
        _Pragma("unroll") for (int i_ = 0; i_ < VPT; ++i_) { const int id_ = tid + NTHR * i_; if (NVC % NTHR == 0 || id_ < NVC) { const int row_ = id_ / VCH, ch_ = id_ % VCH; \
            *(LAS v4u*)(lds + 2 * KB + (buf) * VB + ((row_ >> 3) * NDB + (ch_ >> 2)) * 512 + (row_ & 7) * 64 + (ch_ & 3) * 16) = vreg[i_]; } } } while (0)
    FL_LOAD(0); FL_STORE(0);
    __syncthreads();
    float mrun = m_io, lrun = l_io;
    for (int t = 0; t < nt; ++t) {
        const int buf = t & 1;
        if (t + 1 < nt) FL_LOAD(t + 1);
        if (pol.active(t)) {
            const LAS unsigned char* kb = lds + buf * KB + r32 * KSTRB + hi * 16;
            f32x16 p0, p1;
#pragma unroll
            for (int r = 0; r < 16; ++r) { p0[r] = 0.f; p1[r] = 0.f; }
#pragma unroll
            for (int s = 0; s < DQK / 16; ++s) {
                const bf16x8 a0 = *(const LAS bf16x8*)(kb + s * 32), a1 = *(const LAS bf16x8*)(kb + 32 * KSTRB + s * 32);
                p0 = __builtin_amdgcn_mfma_f32_32x32x16_bf16(a0, qf[s], p0, 0, 0, 0);
                p1 = __builtin_amdgcn_mfma_f32_32x32x16_bf16(a1, qf[s], p1, 0, 0, 0); }
            pol.mask(t, p0, p1);
            float mx = fmaxf(p0[0], p1[0]);
#pragma unroll
            for (int r = 1; r < 16; ++r) mx = fmaxf(mx, fmaxf(p0[r], p1[r]));
            mx = halves_max(mx);
            const float mnew = fmaxf(mrun, mx), alpha = fast_exp2(mrun - mnew); mrun = mnew;
            float rs = 0.f;
#pragma unroll
            for (int r = 0; r < 16; ++r) { p0[r] = fast_exp2(p0[r] - mnew); p1[r] = fast_exp2(p1[r] - mnew); rs += p0[r] + p1[r]; }
            lrun = lrun * alpha + rs;
#pragma unroll
            for (int db = 0; db < NDB; ++db)
#pragma unroll
                for (int r = 0; r < 16; ++r) o[db][r] *= alpha;
            bf16x8 pf[4];
#pragma unroll
            for (int ks = 0; ks < 4; ++ks) { v4u w;
                if (ks < 2) { w.x = cvtpk(p0[8 * ks + 0], p0[8 * ks + 1]); w.y = cvtpk(p0[8 * ks + 2], p0[8 * ks + 3]); w.z = cvtpk(p0[8 * ks + 4], p0[8 * ks + 5]); w.w = cvtpk(p0[8 * ks + 6], p0[8 * ks + 7]); }
                else { const int k2 = ks - 2; w.x = cvtpk(p1[8 * k2 + 0], p1[8 * k2 + 1]); w.y = cvtpk(p1[8 * k2 + 2], p1[8 * k2 + 3]); w.z = cvtpk(p1[8 * k2 + 4], p1[8 * k2 + 5]); w.w = cvtpk(p1[8 * k2 + 6], p1[8 * k2 + 7]); }
                pf[ks] = __builtin_bit_cast(bf16x8, w); }
            const LAS unsigned char* vb = lds + 2 * KB + buf * VB + (4 * hi + ((lane & 15) >> 2)) * 64 + ((lane >> 4) & 1) * 32 + (lane & 3) * 8;
#pragma unroll
            for (int db = 0; db < NDB; ++db)
#pragma unroll
                for (int ks = 0; ks < 4; ++ks) {
                    const s16x4 lo = vtr(vb + ((2 * ks) * NDB + db) * 512), hh = vtr(vb + ((2 * ks + 1) * NDB + db) * 512);
                    const bf16x8 vf = {lo[0], lo[1], lo[2], lo[3], hh[0], hh[1], hh[2], hh[3]};
                    o[db] = __builtin_amdgcn_mfma_f32_32x32x16_bf16(vf, pf[ks], o[db], 0, 0, 0); }
        }
        if (t + 1 < nt) FL_STORE(buf ^ 1);
        __syncthreads();
    }
    m_io = mrun; l_io = lrun;
#undef FL_LOAD
#undef FL_STORE
}

template <int NDB>
__device__ __forceinline__ void store_o(const f32x16 (&o)[NDB], float scale, bf16* orow, int hi) {
#pragma unroll
    for (int db = 0; db < NDB; ++db)
#pragma unroll
        for (int g = 0; g < 4; ++g) {
            const unsigned lo = cvtpk(o[db][4 * g] * scale, o[db][4 * g + 1] * scale), hh = cvtpk(o[db][4 * g + 2] * scale, o[db][4 * g + 3] * scale);
            *(GAS unsigned long long*)(orow + 32 * db + 8 * g + 4 * hi) = (unsigned long long)lo | ((unsigned long long)hh << 32); }
}

struct PolMLA {
    static constexpr int DQK = 96, DV = 64;
    const bf16 *kn, *kr, *v; int ntiles;
    __device__ __forceinline__ const bf16* kptr(int t, int row, int ch) const { const size_t kv = (size_t)t * 64 + row; return ch < 8 ? kn + kv * 1024 + ch * 8 : kr + kv * 768 + (ch - 8) * 8; }
    __device__ __forceinline__ const bf16* vptr(int t, int row, int ch) const { return v + ((size_t)t * 64 + row) * 1024 + ch * 8; }
    __device__ __forceinline__ bool active(int) const { return true; }
    __device__ __forceinline__ void mask(int, f32x16&, f32x16&) const {}
};
__device__ __forceinline__ void mla_unit(unsigned char* ws, LAS unsigned char* lds, int b, int h, int qb, int wave, int lane) {
    const int r32 = lane & 31, hi = lane >> 5; const size_t row = (size_t)b * SEQ + qb * 256 + wave * 32 + r32;
    bf16* qn = (bf16*)(ws + WS_MQN) + row * 512 + h * 64; const bf16* qr = (const bf16*)(ws + WS_MQR) + row * 256 + h * 32;
    bf16x8 qf[6];
#pragma unroll
    for (int s = 0; s < 4; ++s) qf[s] = *(const GAS bf16x8*)(qn + 16 * s + 8 * hi);
#pragma unroll
    for (int s = 0; s < 2; ++s) {
        const v4u raw = *(const GAS v4u*)(qr + 16 * s + 8 * hi);
        float x[8] = {bf_lo(raw.x), bf_hi(raw.x), bf_lo(raw.y), bf_hi(raw.y), bf_lo(raw.z), bf_hi(raw.z), bf_lo(raw.w), bf_hi(raw.w)};
        rope4(x, (const f32x2*)(ws + WS_ROPE32) + (size_t)(qb * 256 + wave * 32 + r32) * 16 + 8 * s + 4 * hi);
        v4u w; w.x = cvtpk(x[0], x[1]); w.y = cvtpk(x[2], x[3]); w.z = cvtpk(x[4], x[5]); w.w = cvtpk(x[6], x[7]);
        qf[4 + s] = __builtin_bit_cast(bf16x8, w); }
    PolMLA pol; pol.kn = (const bf16*)(ws + WS_KVB) + (size_t)b * SEQ * 1024 + h * 64; pol.kr = (const bf16*)(ws + WS_LAT) + (size_t)b * SEQ * 768 + 640;
    pol.v = (const bf16*)(ws + WS_KVB) + (size_t)b * SEQ * 1024 + 512 + h * 64; pol.ntiles = SEQ / 64;
    f32x16 o[2];
#pragma unroll
    for (int r = 0; r < 16; ++r) { o[0][r] = 0.f; o[1][r] = 0.f; }
    float m = -1e30f, l = 0.f;
    flash_run(pol, lds, qf, o, m, l);
    l = halves_sum(l);
    store_o<2>(o, fast_rcp(l), qn, hi);
}

struct PolDiff {
    static constexpr int DQK = 64, DV = 128;
    const bf16 *k, *v; int ntiles;
    __device__ __forceinline__ const bf16* kptr(int t, int row, int ch) const { return k + ((size_t)t * 64 + row) * 512 + ch * 8; }
    __device__ __forceinline__ const bf16* vptr(int t, int row, int ch) const { return v + ((size_t)t * 64 + row) * 512 + ch * 8; }
    __device__ __forceinline__ bool active(int) const { return true; }
    __device__ __forceinline__ void mask(int, f32x16&, f32x16&) const {}
};
__device__ __forceinline__ void diff_unit(unsigned char* ws, LAS unsigned char* lds, int b, int h, int qb, int wave, int lane, float lam, float post, const float* subln) {
    const int r32 = lane & 31, hi = lane >> 5; const size_t row = (size_t)b * SEQ + qb * 256 + wave * 32 + r32;
    bf16* q = (bf16*)(ws + WS_DIFQ) + row * 512 + h * 128;
    bf16* scr = (bf16*)(ws + WS_DSCR) + ((size_t)blockIdx.x * 256 + wave * 32 + r32) * 128;
    for (int mp = 0; mp < 2; ++mp) {
        bf16x8 qf[4];
#pragma unroll
        for (int s = 0; s < 4; ++s) qf[s] = *(const GAS bf16x8*)(q + 64 * mp + 16 * s + 8 * hi);
        PolDiff pol; pol.k = (const bf16*)(ws + WS_DIFK) + (size_t)b * SEQ * 512 + h * 128 + 64 * mp; pol.v = (const bf16*)(ws + WS_DIFV) + (size_t)b * SEQ * 512 + h * 128; pol.ntiles = SEQ / 64;
        f32x16 o[4];
#pragma unroll
        for (int d = 0; d < 4; ++d)
#pragma unroll
            for (int r = 0; r < 16; ++r) o[d][r] = 0.f;
        float m = -1e30f, l = 0.f;
        flash_run(pol, lds, qf, o, m, l);
        const float il = fast_rcp(halves_sum(l));
        if (mp == 0) {
            store_o<4>(o, il, scr, hi);
            asm volatile("s_waitcnt vmcnt(0)" ::: "memory");
        } else {
            const float il2 = lam * il; float ss = 0.f;
#pragma unroll
            for (int d = 0; d < 4; ++d)
#pragma unroll
                for (int g = 0; g < 4; ++g) { const unsigned long long w = *(const GAS unsigned long long*)(scr + 32 * d + 8 * g + 4 * hi); const unsigned w0 = (unsigned)w, w1 = (unsigned)(w >> 32);
                    o[d][4 * g] = bf_lo(w0) - il2 * o[d][4 * g]; o[d][4 * g + 1] = bf_hi(w0) - il2 * o[d][4 * g + 1]; o[d][4 * g + 2] = bf_lo(w1) - il2 * o[d][4 * g + 2]; o[d][4 * g + 3] = bf_hi(w1) - il2 * o[d][4 * g + 3];
                    ss += o[d][4 * g] * o[d][4 * g] + o[d][4 * g + 1] * o[d][4 * g + 1] + o[d][4 * g + 2] * o[d][4 * g + 2] + o[d][4 * g + 3] * o[d][4 * g + 3]; }
            ss = halves_sum(ss);
            const float rn = post / sqrtf(ss * (1.f / 128.f) + LN_EPS);
#pragma unroll
            for (int d = 0; d < 4; ++d)
#pragma unroll
                for (int g = 0; g < 4; ++g) { const f32x4 gv = *(const GAS f32x4*)(subln + 32 * d + 8 * g + 4 * hi);
                    o[d][4 * g] *= gv.x; o[d][4 * g + 1] *= gv.y; o[d][4 * g + 2] *= gv.z; o[d][4 * g + 3] *= gv.w; }
            store_o<4>(o, rn, q, hi);
        }
    }
}

struct PolSWA {
    static constexpr int DQK = 64, DV = 64;
    const bf16 *k, *v; int ntiles; int kv0; int qw; int q;
    int hi;
    __device__ __forceinline__ int kvrow(int t, int row) const { int kv = kv0 + t * 64 + row; kv = kv < 0 ? 0 : kv; return kv > SEQ - 1 ? SEQ - 1 : kv; }
    __device__ __forceinline__ const bf16* kptr(int t, int row, int ch) const { return k + (size_t)kvrow(t, row) * 256 + ch * 8; }
    __device__ __forceinline__ const bf16* vptr(int t, int row, int ch) const { return v + (size_t)kvrow(t, row) * 256 + ch * 8; }
    __device__ __forceinline__ bool active(int t) const { const int lo = kv0 + t * 64; return (lo + 63 >= qw - 128) && (lo <= qw + 31 + 128) && (lo + 63 >= 0) && (lo < SEQ); }
    __device__ __forceinline__ void mask(int t, f32x16& p0, f32x16& p1) const {
        const int lo = kv0 + t * 64;
#pragma unroll
        for (int r = 0; r < 16; ++r) { const int kv = lo + crow(r, hi); const int d0 = q - kv, d1 = d0 - 32;
            if (d0 > 128 || d0 < -128 || kv < 0 || kv >= SEQ) p0[r] = -INFINITY;
            if (d1 > 128 || d1 < -128 || kv + 32 < 0 || kv + 32 >= SEQ) p1[r] = -INFINITY; }
    }
};
__device__ __forceinline__ void swa_unit(unsigned char* ws, LAS unsigned char* lds, int b, int h, int qb, int wave, int lane, float sink2) {
    const int r32 = lane & 31, hi = lane >> 5; const int qw = qb * 256 + wave * 32; const size_t row = (size_t)b * SEQ + qw + r32;
    bf16* q = (bf16*)(ws + WS_SWAQ) + row * 512 + h * 64;
    bf16x8 qf[4];
#pragma unroll
    for (int s = 0; s < 4; ++s) qf[s] = *(const GAS bf16x8*)(q + 16 * s + 8 * hi);
    PolSWA pol; pol.k = (const bf16*)(ws + WS_SWAKV) + (size_t)b * SEQ * 256 + (h >> 2) * 64; pol.v = pol.k + 128;
    pol.ntiles = 8; pol.kv0 = qb * 256 - 128; pol.qw = qw; pol.q = qw + r32; pol.hi = hi;
    f32x16 o[2];
#pragma unroll
    for (int r = 0; r < 16; ++r) { o[0][r] = 0.f; o[1][r] = 0.f; }
    float m = -1e30f, l = 0.f;
    flash_run(pol, lds, qf, o, m, l);
    l = halves_sum(l) + fast_exp2(sink2 - m);
    store_o<2>(o, fast_rcp(l), q, hi);
}

struct PolNAT {
    static constexpr int DQK = 64, DV = 64;
    const bf16 *k, *v; int ntiles; int tr0; int r; int j; int hi; const LAS float* bias;
    __device__ __forceinline__ const bf16* kptr(int t, int row, int ch) const { return k + ((size_t)(tr0 + t) * 64 + row) * 512 + ch * 8; }
    __device__ __forceinline__ const bf16* vptr(int t, int row, int ch) const { return v + ((size_t)(tr0 + t) * 64 + row) * 512 + ch * 8; }
    __device__ __forceinline__ int r0() const { int x = r - 4; x = x < 0 ? 0 : x; return x > 120 ? 120 : x; }
    __device__ __forceinline__ bool active(int t) const { const int kr = tr0 + t, a = r0(); return kr >= a && kr < a + 8; }
    __device__ __forceinline__ void mask(int t, f32x16& p0, f32x16& p1) const {
        int c0 = j - 8; c0 = c0 < 0 ? 0 : c0; c0 = c0 > 48 ? 48 : c0;
        const LAS float* brow = bias + ((tr0 + t) - r + 7) * 31 + (15 - j);
#pragma unroll
        for (int rr = 0; rr < 16; ++rr) { const int kc = crow(rr, hi);
            p0[rr] = (kc >= c0 && kc < c0 + 16) ? p0[rr] + brow[kc] : -INFINITY;
            p1[rr] = (kc + 32 >= c0 && kc + 32 < c0 + 16) ? p1[rr] + brow[kc + 32] : -INFINITY; }
    }
};
__device__ __forceinline__ void nat_unit(unsigned char* ws, LAS unsigned char* lds, const LAS float* bias_all, int b, int h, int rg, int wave, int lane) {
    const int r32 = lane & 31, hi = lane >> 5; const int r = 4 * rg + (wave >> 1), j = 32 * (wave & 1) + r32; const size_t row = (size_t)b * SEQ + r * 64 + j;
    bf16* q = (bf16*)(ws + WS_NATQ) + row * 512 + h * 64;
    bf16x8 qf[4];
#pragma unroll
    for (int s = 0; s < 4; ++s) qf[s] = *(const GAS bf16x8*)(q + 16 * s + 8 * hi);
    int ra = 4 * rg - 4; ra = ra < 0 ? 0 : ra; ra = ra > 120 ? 120 : ra; int rb = 4 * rg - 1; rb = rb < 0 ? 0 : rb; rb = rb > 120 ? 120 : rb;
    PolNAT pol; pol.k = (const bf16*)(ws + WS_NATK) + (size_t)b * SEQ * 512 + h * 64; pol.v = (const bf16*)(ws + WS_NATV) + (size_t)b * SEQ * 512 + h * 64;
    pol.tr0 = ra; pol.ntiles = rb + 7 - ra + 1; pol.r = r; pol.j = j; pol.hi = hi; pol.bias = bias_all + h * 465;
    f32x16 o[2];
#pragma unroll
    for (int rr = 0; rr < 16; ++rr) { o[0][rr] = 0.f; o[1][rr] = 0.f; }
    float m = -1e30f, l = 0.f;
    flash_run(pol, lds, qf, o, m, l);
    l = halves_sum(l);
    store_o<2>(o, fast_rcp(l), q, hi);
}

__device__ __forceinline__ unsigned f2key(float f) { const unsigned u = __float_as_uint(f); return (u & 0x80000000u) ? ~u : (u | 0x80000000u); }
__device__ __forceinline__ float key2f(unsigned k) { const unsigned u = (k & 0x80000000u) ? (k & 0x7fffffffu) : ~k; return __uint_as_float(u); }
__device__ __forceinline__ unsigned umax2(unsigned a, unsigned b) { return a > b ? a : b; }
__device__ __forceinline__ unsigned zero_if_eq(unsigned k, unsigned M) { unsigned r; asm("v_cmp_ne_u32_e32 vcc, %1, %2\n\tv_cndmask_b32_e32 %0, 0, %1, vcc" : "=v"(r) : "v"(k), "v"(M) : "vcc"); return r; }
__device__ __forceinline__ void take_if_eq(unsigned& p, unsigned& k, unsigned M, unsigned pay) { unsigned nk; asm("v_cmp_eq_u32_e32 vcc, %2, %3\n\tv_cndmask_b32_e32 %0, %0, %4, vcc\n\tv_cndmask_b32_e64 %1, %2, 0, vcc" : "+v"(p), "=&v"(nk) : "v"(k), "v"(M), "v"(pay) : "vcc"); k = nk; }

__device__ __forceinline__ void peer_route_unit(unsigned char* ws, LAS unsigned char* lds, int tile, int h, int wave, int lane) {
    int tid = threadIdx.x; asm volatile("" : "+v"(tid)); const int r32 = lane & 31, hi = lane >> 5;
    constexpr int KSTR = 272;
    const bf16* keys = (const bf16*)(ws + WS_KEYS) + (size_t)h * 2 * 128 * 128;
    for (int i = tid; i < 2 * 128 * 16; i += NTHR) { const int row = i >> 4, ch = i & 15; *(LAS v4u*)(lds + row * KSTR + ch * 16) = *(const GAS v4u*)(keys + (size_t)row * 128 + ch * 8); }
    __syncthreads();
    const size_t tok = (size_t)tile * 256 + wave * 32 + r32;
    const bf16* q = (const bf16*)(ws + WS_QP) + tok * 2048 + h * 256;
    unsigned list[2][16];
#pragma unroll
    for (int p = 0; p < 2; ++p) {
        bf16x8 qf[8];
#pragma unroll
        for (int s = 0; s < 8; ++s) qf[s] = *(const GAS bf16x8*)(q + p * 128 + 16 * s + 8 * hi);
        unsigned key[64];
#pragma unroll
        for (int nb = 0; nb < 4; ++nb) {
            f32x16 acc;
#pragma unroll
            for (int r = 0; r < 16; ++r) acc[r] = 0.f;
            const LAS unsigned char* kb = lds + (p * 128 + 32 * nb + r32) * KSTR + hi * 16;
#pragma unroll
            for (int s = 0; s < 8; ++s) acc = __builtin_amdgcn_mfma_f32_32x32x16_bf16(*(const LAS bf16x8*)(kb + s * 32), qf[s], acc, 0, 0, 0);
#pragma unroll
            for (int r = 0; r < 16; ++r) { const int n = 32 * nb + crow(r, hi); key[nb * 16 + r] = (f2key(acc[r]) & ~127u) | (unsigned)(127 - n); }
        }
#pragma unroll
        for (int rd = 0; rd < 16; ++rd) {
            unsigned mx = key[0];
#pragma unroll
            for (int i = 1; i < 64; ++i) mx = umax2(mx, key[i]);
            const unsigned M = halves_umax(mx); list[p][rd] = M;
#pragma unroll
            for (int i = 0; i < 64; ++i) key[i] = zero_if_eq(key[i], M);
        }
    }
    constexpr int CA[50] = {0,0,0,0,0,0,0,0,0,0,0,0,0,0,0,0, 1,1,1,1,1,1,1,1, 2,2,2,2,2, 3,3,3,3, 4,4,4, 5,5, 6,6, 7,7, 8,9,10,11,12,13,14,15};
    constexpr int CB[50] = {0,1,2,3,4,5,6,7,8,9,10,11,12,13,14,15, 0,1,2,3,4,5,6,7, 0,1,2,3,4, 0,1,2,3, 0,1,2, 0,1, 0,1, 0,1, 0,0,0,0,0,0,0,0};
    unsigned ck[50], pay[50];
#pragma unroll
    for (int c = 0; c < 50; ++c) { const unsigned ka = list[0][CA[c]], kb2 = list[1][CB[c]];
        const float s = key2f(ka & ~127u) + key2f(kb2 & ~127u);
        ck[c] = (f2key(s) & ~63u) | (unsigned)(63 - c); pay[c] = ((127u - (ka & 127u)) << 7) | (127u - (kb2 & 127u)); }
    float ss[16]; unsigned sp[16];
#pragma unroll
    for (int rd = 0; rd < 16; ++rd) {
        unsigned mx = ck[0];
#pragma unroll
        for (int c = 1; c < 50; ++c) mx = umax2(mx, ck[c]);
        unsigned pp = 0u;
#pragma unroll
        for (int c = 0; c < 50; ++c) take_if_eq(pp, ck[c], mx, pay[c]);
        ss[rd] = key2f(mx & ~63u); sp[rd] = pp;
    }
    float sum = 0.f;
    const float smax = ss[0];
#pragma unroll
    for (int k = 0; k < 16; ++k) { ss[k] = __expf(ss[k] - smax); sum += ss[k]; }
    const float inv = 1.f / sum;
    if (hi == 0) {
        int* pi = (int*)(ws + WS_PIDX) + tok * 128 + h * 16; float* pg = (float*)(ws + WS_PGATE) + tok * 128 + h * 16;
#pragma unroll
        for (int k = 0; k < 16; k += 4) { v4u iv; iv.x = sp[k]; iv.y = sp[k + 1]; iv.z = sp[k + 2]; iv.w = sp[k + 3]; *(GAS v4u*)(pi + k) = iv;
            f32x4 gv; gv.x = ss[k] * inv; gv.y = ss[k + 1] * inv; gv.z = ss[k + 2] * inv; gv.w = ss[k + 3] * inv; *(GAS f32x4*)(pg + k) = gv; }
    }
    __syncthreads();
}

__device__ __forceinline__ float dot2u(unsigned w, unsigned x, float acc) { return __builtin_amdgcn_fdot2_f32_bf16(__builtin_bit_cast(bf16x2_t, w), __builtin_bit_cast(bf16x2_t, x), acc, false); }
__device__ __forceinline__ float dot8(const v4u a, const v4u x, float acc) {
    const unsigned a0 = a.x, a1 = a.y, a2 = a.z, a3 = a.w, x0 = x.x, x1 = x.y, x2 = x.z, x3 = x.w;
    acc = dot2u(a0, x0, acc); acc = dot2u(a1, x1, acc); acc = dot2u(a2, x2, acc); acc = dot2u(a3, x3, acc);
    return acc;
}
__device__ __forceinline__ void axpy8(float* o, float w, const v4u v) {
    o[0] += w * bf_lo(v.x); o[1] += w * bf_hi(v.x); o[2] += w * bf_lo(v.y); o[3] += w * bf_hi(v.y); o[4] += w * bf_lo(v.z); o[5] += w * bf_hi(v.z); o[6] += w * bf_lo(v.w); o[7] += w * bf_hi(v.w);
}
__device__ __forceinline__ void peer_token(unsigned char* ws, float* xio, const float* gffn, const float* lng, const float* lnb, size_t tok, int lane) {
    const bf16* u2 = (const bf16*)(ws + WS_U) + tok * 1024;
    const v4u xa = *(const GAS v4u*)(u2 + 8 * lane), xb = *(const GAS v4u*)(u2 + 512 + 8 * lane);
    const int* pi = (const int*)(ws + WS_PIDX) + tok * 128; const float* pg = (const float*)(ws + WS_PGATE) + tok * 128;
    const int ia = pi[lane], ib = pi[64 + lane]; const float ga = pg[lane], gb = pg[64 + lane];
    const bf16* ut = (const bf16*)(ws + WS_UTAB) + 8 * lane; const bf16* vt = (const bf16*)(ws + WS_VTAB) + 8 * lane;
    float out[16];
#pragma unroll
    for (int i = 0; i < 16; ++i) out[i] = 0.f;
    const int j3 = lane >> 3;
    for (int eb = 0; eb < 16; ++eb) {
        const int src = eb < 8 ? ia : ib; const float gsrc = eb < 8 ? ga : gb; const int base = (eb & 7) * 8;
        int e[8];
#pragma unroll
        for (int j = 0; j < 8; ++j) e[j] = __builtin_amdgcn_readlane(src, base + j);
        v4u ua[8], ub[8], va[8], vb[8];
#pragma unroll
        for (int j = 0; j < 8; ++j) { ua[j] = *(const GAS v4u*)(ut + (size_t)e[j] * 1024); ub[j] = *(const GAS v4u*)(ut + (size_t)e[j] * 1024 + 512); }
#pragma unroll
        for (int j = 0; j < 8; ++j) { va[j] = *(const GAS v4u*)(vt + (size_t)e[j] * 1024); vb[j] = *(const GAS v4u*)(vt + (size_t)e[j] * 1024 + 512); }
        float d[8];
#pragma unroll
        for (int j = 0; j < 8; ++j) d[j] = dot8(ub[j], xb, dot8(ua[j], xa, 0.f));
        float t4[4], t2[2], t1;
        { const bool up = (lane & 32) != 0;
#pragma unroll
          for (int j = 0; j < 4; ++j) { const float keep = up ? d[j + 4] : d[j], send = up ? d[j] : d[j + 4]; t4[j] = keep + __shfl_xor(send, 32); } }
        { const bool up = (lane & 16) != 0;
#pragma unroll
          for (int j = 0; j < 2; ++j) { const float keep = up ? t4[j + 2] : t4[j], send = up ? t4[j] : t4[j + 2]; t2[j] = keep + __shfl_xor(send, 16); } }
        { const bool up = (lane & 8) != 0; const float keep = up ? t2[1] : t2[0], send = up ? t2[0] : t2[1]; t1 = keep + __shfl_xor(send, 8); }
        t1 += __shfl_xor(t1, 4); t1 += __shfl_xor(t1, 2); t1 += __shfl_xor(t1, 1);
        const float gate = __shfl(gsrc, base + j3);
        const float w = gate * 0.5f * t1 * (1.f + erff(t1 * 0.70710678118654752f));
#pragma unroll
        for (int j = 0; j < 8; ++j) { const float wj = __uint_as_float(__builtin_amdgcn_readlane(__float_as_uint(w), 8 * j)); axpy8(out, wj, va[j]); axpy8(out + 8, wj, vb[j]); }
    }
#ifdef DBG_NO_PEER
#pragma unroll
    for (int i = 0; i < 16; ++i) out[i] = 0.f;
#endif
    float* xr = xio + tok * 1024; float z[16]; float s = 0.f;
#pragma unroll
    for (int hh = 0; hh < 2; ++hh)
#pragma unroll
        for (int q = 0; q < 2; ++q) { const int c = 512 * hh + 8 * lane + 4 * q; const f32x4 xv = *(const GAS f32x4*)(xr + c), gv = *(const GAS f32x4*)(gffn + c);
            z[8 * hh + 4 * q + 0] = DN_ALPHA * xv.x + gv.x * out[8 * hh + 4 * q + 0]; z[8 * hh + 4 * q + 1] = DN_ALPHA * xv.y + gv.y * out[8 * hh + 4 * q + 1];
            z[8 * hh + 4 * q + 2] = DN_ALPHA * xv.z + gv.z * out[8 * hh + 4 * q + 2]; z[8 * hh + 4 * q + 3] = DN_ALPHA * xv.w + gv.w * out[8 * hh + 4 * q + 3]; }
#pragma unroll
    for (int i = 0; i < 16; ++i) s += z[i];
    const float mean = wave_sum(s) * (1.f / DM); float s2 = 0.f;
#pragma unroll
    for (int i = 0; i < 16; ++i) { z[i] -= mean; s2 += z[i] * z[i]; }
    const float rstd = 1.f / sqrtf(wave_sum(s2) * (1.f / DM) + LN_EPS);
#pragma unroll
    for (int hh = 0; hh < 2; ++hh)
#pragma unroll
        for (int q = 0; q < 2; ++q) { const int c = 512 * hh + 8 * lane + 4 * q; const f32x4 g = *(const GAS f32x4*)(lng + c), bb = *(const GAS f32x4*)(lnb + c);
            f32x4 y; y.x = z[8 * hh + 4 * q + 0] * rstd * g.x + bb.x; y.y = z[8 * hh + 4 * q + 1] * rstd * g.y + bb.y; y.z = z[8 * hh + 4 * q + 2] * rstd * g.z + bb.z; y.w = z[8 * hh + 4 * q + 3] * rstd * g.w + bb.w;
            *(GAS f32x4*)(xr + c) = y; }
}

#define NV_INSERT(val, idx, V, I) do { float v_ = (val); int i_ = (idx); _Pragma("unroll") for (int z_ = 0; z_ < 16; ++z_) { const bool gt_ = v_ > V[z_]; const float tv_ = V[z_]; const int ti_ = I[z_]; V[z_] = gt_ ? v_ : tv_; I[z_] = gt_ ? i_ : ti_; v_ = gt_ ? tv_ : v_; i_ = gt_ ? ti_ : i_; } } while (0)
__device__ __forceinline__ void peer_route_naive_unit(unsigned char* ws, LAS unsigned char* lds, int tile, int h, int tid) {
    const bf16* keys = (const bf16*)(ws + WS_KEYS) + (size_t)h * 2 * 128 * 128;
    for (int i = tid; i < 2 * 128 * 16; i += NTHR) *(LAS v4u*)(lds + i * 16) = *(const GAS v4u*)(keys + (size_t)i * 8);
    __syncthreads();
    const size_t tok = (size_t)tile * 512 + tid;
    const bf16* q = (const bf16*)(ws + WS_QP) + tok * 2048 + h * 256;
    float s1[16], s2[16]; int i1[16], i2[16];
#pragma unroll
    for (int z = 0; z < 16; ++z) { s1[z] = -INFINITY; s2[z] = -INFINITY; i1[z] = 0; i2[z] = 0; }
    for (int p = 0; p < 2; ++p) {
        for (int n = 0; n < 128; ++n) {
            float d = 0.f;
#pragma unroll 4
            for (int c = 0; c < 16; ++c) { const v4u kk = *(const LAS v4u*)(lds + ((p * 128 + n) * 16 + c) * 16); const v4u qq = *(const GAS v4u*)(q + p * 128 + 8 * c);
                d += bf_lo(kk.x) * bf_lo(qq.x) + bf_hi(kk.x) * bf_hi(qq.x) + bf_lo(kk.y) * bf_lo(qq.y) + bf_hi(kk.y) * bf_hi(qq.y)
                   + bf_lo(kk.z) * bf_lo(qq.z) + bf_hi(kk.z) * bf_hi(qq.z) + bf_lo(kk.w) * bf_lo(qq.w) + bf_hi(kk.w) * bf_hi(qq.w); }
            if (p == 0) NV_INSERT(d, n, s1, i1); else NV_INSERT(d, n, s2, i2);
        }
    }
    float ts[16]; int ti[16];
#pragma unroll
    for (int z = 0; z < 16; ++z) { ts[z] = -INFINITY; ti[z] = 0; }
#pragma unroll
    for (int a = 0; a < 16; ++a)
#pragma unroll
        for (int b = 0; b < 16; ++b) NV_INSERT(s1[a] + s2[b], i1[a] * 128 + i2[b], ts, ti);
    float sum = 0.f; float e[16];
#pragma unroll
    for (int z = 0; z < 16; ++z) { e[z] = __expf(ts[z] - ts[0]); sum += e[z]; }
    int* pi = (int*)(ws + WS_PIDX) + tok * 128 + h * 16; float* pg = (float*)(ws + WS_PGATE) + tok * 128 + h * 16;
#pragma unroll
    for (int z = 0; z < 16; ++z) { pi[z] = ti[z]; pg[z] = e[z] / sum; }
    __syncthreads();
}
__device__ __forceinline__ void peer_token_naive(unsigned char* ws, float* xio, const float* gffn, const float* lng, const float* lnb, size_t tok, int lane) {
    const bf16* u2 = (const bf16*)(ws + WS_U) + tok * 1024;
    float x[16], out[16];
    { const v4u xa = *(const GAS v4u*)(u2 + 8 * lane), xb = *(const GAS v4u*)(u2 + 512 + 8 * lane);
      x[0] = bf_lo(xa.x); x[1] = bf_hi(xa.x); x[2] = bf_lo(xa.y); x[3] = bf_hi(xa.y); x[4] = bf_lo(xa.z); x[5] = bf_hi(xa.z); x[6] = bf_lo(xa.w); x[7] = bf_hi(xa.w);
      x[8] = bf_lo(xb.x); x[9] = bf_hi(xb.x); x[10] = bf_lo(xb.y); x[11] = bf_hi(xb.y); x[12] = bf_lo(xb.z); x[13] = bf_hi(xb.z); x[14] = bf_lo(xb.w); x[15] = bf_hi(xb.w); }
#pragma unroll
    for (int i = 0; i < 16; ++i) out[i] = 0.f;
    const int* pi = (const int*)(ws + WS_PIDX) + tok * 128; const float* pg = (const float*)(ws + WS_PGATE) + tok * 128;
    for (int e = 0; e < 128; ++e) {
        const int idx = pi[e]; const float g = pg[e];
        const bf16* ur = (const bf16*)(ws + WS_UTAB) + (size_t)idx * 1024; const bf16* vr = (const bf16*)(ws + WS_VTAB) + (size_t)idx * 1024;
        const v4u a = *(const GAS v4u*)(ur + 8 * lane), b = *(const GAS v4u*)(ur + 512 + 8 * lane);
        float d = bf_lo(a.x) * x[0] + bf_hi(a.x) * x[1] + bf_lo(a.y) * x[2] + bf_hi(a.y) * x[3] + bf_lo(a.z) * x[4] + bf_hi(a.z) * x[5] + bf_lo(a.w) * x[6] + bf_hi(a.w) * x[7]
                + bf_lo(b.x) * x[8] + bf_hi(b.x) * x[9] + bf_lo(b.y) * x[10] + bf_hi(b.y) * x[11] + bf_lo(b.z) * x[12] + bf_hi(b.z) * x[13] + bf_lo(b.w) * x[14] + bf_hi(b.w) * x[15];
        d = wave_sum(d);
        const float w = g * 0.5f * d * (1.f + erff(d * 0.70710678118654752f));
        const v4u c = *(const GAS v4u*)(vr + 8 * lane), dd = *(const GAS v4u*)(vr + 512 + 8 * lane);
        axpy8(out, w, c); axpy8(out + 8, w, dd);
    }
    float* xr = xio + tok * 1024; float z[16]; float s = 0.f;
#pragma unroll
    for (int hh = 0; hh < 2; ++hh)
#pragma unroll
        for (int k = 0; k < 8; ++k) { const int c = 512 * hh + 8 * lane + k; z[8 * hh + k] = DN_ALPHA * xr[c] + gffn[c] * out[8 * hh + k]; s += z[8 * hh + k]; }
    const float mean = wave_sum(s) * (1.f / DM); float s2 = 0.f;
#pragma unroll
    for (int i = 0; i < 16; ++i) { z[i] -= mean; s2 += z[i] * z[i]; }
    const float rstd = 1.f / sqrtf(wave_sum(s2) * (1.f / DM) + LN_EPS);
#pragma unroll
    for (int hh = 0; hh < 2; ++hh)
#pragma unroll
        for (int k = 0; k < 8; ++k) { const int c = 512 * hh + 8 * lane + k; xr[c] = z[8 * hh + k] * rstd * lng[c] + lnb[c]; }
}

__device__ __forceinline__ void ln1_row(float* zrow, const float* g1, const float* b1, const float* sh, const float* sc, bf16* urow, int lane) {
    GAS f32x4* xr = (GAS f32x4*)zrow + lane;
    f32x4 v[4]; float s = 0.f;
#pragma unroll
    for (int j = 0; j < 4; ++j) { v[j] = xr[64 * j]; s += (v[j].x + v[j].y) + (v[j].z + v[j].w); }
    float mean = wave_sum(s) * (1.f / DM); float s2 = 0.f;
#pragma unroll
    for (int j = 0; j < 4; ++j) { v[j] = v[j] - mean; s2 += (v[j].x * v[j].x + v[j].y * v[j].y) + (v[j].z * v[j].z + v[j].w * v[j].w); }
    float rstd = 1.f / sqrtf(wave_sum(s2) * (1.f / DM) + LN_EPS);
    s = 0.f;
#pragma unroll
    for (int j = 0; j < 4; ++j) { const f32x4 g = ((const GAS f32x4*)g1)[lane + 64 * j], b = ((const GAS f32x4*)b1)[lane + 64 * j];
        v[j] = v[j] * rstd * g + b; xr[64 * j] = v[j]; s += (v[j].x + v[j].y) + (v[j].z + v[j].w); }
    mean = wave_sum(s) * (1.f / DM); s2 = 0.f;
#pragma unroll
    for (int j = 0; j < 4; ++j) { v[j] = v[j] - mean; s2 += (v[j].x * v[j].x + v[j].y * v[j].y) + (v[j].z * v[j].z + v[j].w * v[j].w); }
    rstd = 1.f / sqrtf(wave_sum(s2) * (1.f / DM) + LN_EPS);
    GAS unsigned long long* o8 = (GAS unsigned long long*)urow + lane;
#pragma unroll
    for (int j = 0; j < 4; ++j) { const f32x4 a = ((const GAS f32x4*)sc)[lane + 64 * j], b = ((const GAS f32x4*)sh)[lane + 64 * j];
        const f32x4 y = v[j] * rstd * (a + 1.f) + b;
        o8[64 * j] = (unsigned long long)pk2(y.x, y.y) | ((unsigned long long)pk2(y.z, y.w) << 32); }
}

#ifndef MK_MULTI
#define MK_MULTI 1
#endif
struct Args { const float* in[27]; float* out; unsigned char* ws; float inv64[32]; float inv32[16]; int ph_lo, ph_hi; };

__global__ void __launch_bounds__(NTHR, 2) fwd_kernel(Args args) {
    extern __shared__ __attribute__((aligned(16))) unsigned char lds_raw[];
    LAS unsigned char* lds = (LAS unsigned char*)lds_raw;
    volatile LAS unsigned* MISC = (volatile LAS unsigned*)(lds + MISC_OFF);
    const int G = gridDim.x; const int bx = blockIdx.x; const int vcu = (G % 8 == 0) ? (bx % 8) * (G / 8) + bx / 8 : bx;
    const int NGW = G * NWAVES;
#define PHASE_IDS int tid = threadIdx.x; asm volatile("" : "+v"(tid)); const int lane = tid & 63, wave = __builtin_amdgcn_readfirstlane(tid >> 6); const int gw = vcu * NWAVES + wave; (void)lane; (void)gw;
    Ptrs P;
#pragma unroll
    for (int i = 0; i < 27; ++i) P.in[i] = args.in[i];
    P.out = args.out; P.ws = args.ws;
    unsigned char* ws = args.ws;
    gu32* ctl = (gu32*)(ws + WS_CTL);
    for (int u = threadIdx.x; u < (LDS_BYTES - LDSCTL_OFF) / 4; u += NTHR) ((LAS unsigned*)(lds + LDSCTL_OFF))[u] = 0u;
    __syncthreads();
    const int lo = args.ph_lo, hi_ph = args.ph_hi;
    XcdBarrier bar; bar.bar = (unsigned*)(ctl + CW_BAR); bar.x = 0; bar.st = nullptr;
    if (hi_ph - lo > 1) bar = xcd_barrier_post((unsigned*)(ctl + CW_BAR), MISC + 8);
#ifndef PHASE_MASK
#define PHASE_MASK 0xFFF
#endif
#ifndef ATT_MASK
#define ATT_MASK 15
#endif
#define PHON(j) (((PHASE_MASK) >> (j)) & 1)
#define IN(k) (lo <= (k) && (k) < hi_ph)
#define SEAM(k) do { if (IN(k) && IN((k) + 1)) xcd_barrier(bar); } while (0)
    float* mod = (float*)(ws + WS_MOD);

    if (PHON(11) && IN(0)) { PHASE_IDS
        compute_mod(P, lds, tid);
        compute_rope(P, args.inv64, args.inv32, vcu * NTHR + tid, G * NTHR);
        convert_weights(P, 0, lds, gw, NGW, wave, lane);
    }
    SEAM(0);

#pragma unroll
    for (int l = 0; l < DEPTH; ++l) {
        const int pb = 1 + 11 * l;
        const float* xin = (l == 0) ? P.in[0] : P.out;
        const float* modl = mod + (size_t)l * 4 * 6144;
        if (PHON(0) && IN(pb + 0)) { PHASE_IDS
            if (l > 0) convert_weights(P, l, lds, gw, NGW, wave, lane);
            for (int m = gw; m < T; m += NGW) { const float* mb = modl + (size_t)(m / SEQ) * 6144; ln_mod_row(xin + (size_t)m * DM, mb, mb + 1024, (bf16*)(ws + WS_U) + (size_t)m * DM, lane); }
        }
        SEAM(pb + 0);
        if (PHON(1) && IN(pb + 1)) { PHASE_IDS
            pg8::Gemm g{(const bf16*)(ws + WS_U), (const bf16*)(ws + WS_WIN), T, NIN, 1024, 1024, 1024}; pg8::StaticOrder S; S.init(T, NIN, G, bx);
            EpiInProj E{ws};
            pg8::gemm_phase(lds, g, S, E);
        }
        SEAM(pb + 1);
        if (PHON(2) && IN(pb + 2)) { PHASE_IDS
            float* rstd = (float*)(ws + WS_RSTD);
            for (int m = gw; m < T; m += NGW) {
                const bf16* row = (const bf16*)(ws + WS_LAT) + (size_t)m * 768;
                float sq = 0.f, skv = 0.f;
                if (lane < 48) { const v4u a = *(const GAS v4u*)(row + 8 * lane);
                    sq = bf_lo(a.x) * bf_lo(a.x) + bf_hi(a.x) * bf_hi(a.x) + bf_lo(a.y) * bf_lo(a.y) + bf_hi(a.y) * bf_hi(a.y) + bf_lo(a.z) * bf_lo(a.z) + bf_hi(a.z) * bf_hi(a.z) + bf_lo(a.w) * bf_lo(a.w) + bf_hi(a.w) * bf_hi(a.w); }
                if (lane < 32) { const v4u a = *(const GAS v4u*)(row + 384 + 8 * lane);
                    skv = bf_lo(a.x) * bf_lo(a.x) + bf_hi(a.x) * bf_hi(a.x) + bf_lo(a.y) * bf_lo(a.y) + bf_hi(a.y) * bf_hi(a.y) + bf_lo(a.z) * bf_lo(a.z) + bf_hi(a.z) * bf_hi(a.z) + bf_lo(a.w) * bf_lo(a.w) + bf_hi(a.w) * bf_hi(a.w); }
                sq = wave_sum(sq); skv = wave_sum(skv);
                if (lane == 0) { rstd[2 * m] = 1.f / sqrtf(sq * (1.f / 384.f) + LN_EPS); rstd[2 * m + 1] = 1.f / sqrtf(skv * (1.f / 256.f) + LN_EPS); }
            }
        }
        SEAM(pb + 2);
        if (PHON(3) && IN(pb + 3)) { PHASE_IDS
            if (ATT_MASK & 1) { pg8::Gemm g{(const bf16*)(ws + WS_LAT), (const bf16*)(ws + WS_QUP), T, 768, 384, 768, 384}; pg8::StaticOrder S; S.init(T, 768, G, bx);
              EpiQup E{ws}; pg8::gemm_phase(lds, g, S, E); }
            if (ATT_MASK & 2) { pg8::Gemm g{(const bf16*)(ws + WS_LAT) + 384, (const bf16*)(ws + WS_KVUP), T, 1024, 256, 768, 256}; pg8::StaticOrder S; S.init(T, 1024, G, bx);
              EpiScaleRow E{(bf16*)(ws + WS_KVB), 1024, (const float*)(ws + WS_RSTD) + 1, 2}; pg8::gemm_phase(lds, g, S, E); }
        }
        SEAM(pb + 3);
        if (PHON(4) && IN(pb + 4)) { PHASE_IDS
            LAS float* bias_all = (LAS float*)(lds + 65536);
            for (int i = tid; i < 8 * 465; i += NTHR) bias_all[i] = P.in[15][(size_t)l * 3720 + i] * LOG2E;
            const float lam_init = 0.8f - 0.6f * expf(-0.3f * (float)l);
            const float d1 = wave_sum(P.in[10][l * 64 + lane] * P.in[11][l * 64 + lane]), d2 = wave_sum(P.in[12][l * 64 + lane] * P.in[13][l * 64 + lane]);
            const float lam = expf(d1) - expf(d2) + lam_init;
            __syncthreads();
            if (ATT_MASK & 1) for (int u = vcu; u < 16 * 32; u += G) { const int bh = u >> 5; diff_unit(ws, lds, bh >> 2, bh & 3, u & 31, wave, lane, lam, 1.f - lam_init, P.in[14] + l * 128); }
            if (ATT_MASK & 2) for (int u = vcu; u < 32 * 32; u += G) { const int bh = u >> 5; mla_unit(ws, lds, bh >> 3, bh & 7, u & 31, wave, lane); }
            if (ATT_MASK & 4) for (int u = vcu; u < 32 * 32; u += G) { const int bh = u >> 5; swa_unit(ws, lds, bh >> 3, bh & 7, u & 31, wave, lane, P.in[5][l * 8 + (bh & 7)] * LOG2E); }
            if (ATT_MASK & 8) for (int u = vcu; u < 32 * 32; u += G) { const int bh = u >> 5; nat_unit(ws, lds, bias_all, bh >> 3, bh & 7, u & 31, wave, lane); }
        }
        SEAM(pb + 4);
        if (PHON(5) && IN(pb + 5)) { PHASE_IDS
            for (int n = 0; n < 4; ++n) {
                { pg8::Gemm g{(const bf16*)(ws + WS_U), (const bf16*)(ws + WS_WG) + (size_t)n * 1024 * 1024, T, 1024, 1024, 1024, 1024}; pg8::StaticOrder S; S.init(T, 1024, G, bx);
                  EpiSigmoid E{(bf16*)(ws + WS_SG)}; pg8::gemm_phase(lds, g, S, E); }
                const size_t ob = (n == 0) ? WS_SWAQ : (n == 1) ? WS_MQN : (n == 2) ? WS_DIFQ : WS_NATQ;
                { pg8::Gemm g{(const bf16*)(ws + ob), (const bf16*)(ws + WS_WB) + (size_t)n * 1024 * 512, T, 1024, 512, 512, 512}; pg8::StaticOrder S; S.init(T, 1024, G, bx);
                  EpiGated E{(const bf16*)(ws + WS_SG), (bf16*)(ws + WS_MERGED), n > 0 ? 1 : 0}; pg8::gemm_phase(lds, g, S, E); }
            }
        }
        SEAM(pb + 5);
        if (PHON(6) && IN(pb + 6)) { PHASE_IDS
            pg8::Gemm g{(const bf16*)(ws + WS_MERGED), (const bf16*)(ws + WS_WO), T, 1024, 1024, 1024, 1024}; pg8::StaticOrder S; S.init(T, 1024, G, bx);
            EpiResid E{xin, P.out, modl + 2048}; pg8::gemm_phase(lds, g, S, E);
        }
        SEAM(pb + 6);
        if (PHON(7) && IN(pb + 7)) { PHASE_IDS
            for (int m = gw; m < T; m += NGW) { const float* mb = modl + (size_t)(m / SEQ) * 6144;
                ln1_row(P.out + (size_t)m * DM, P.in[19] + l * 1024, P.in[20] + l * 1024, mb + 3072, mb + 4096, (bf16*)(ws + WS_U) + (size_t)m * DM, lane); }
            const float* su = P.in[23] + (size_t)l * 16384 * 1024; const float* sv = P.in[24] + (size_t)l * 16384 * 1024;
            bf16* du = (bf16*)(ws + WS_UTAB); bf16* dv = (bf16*)(ws + WS_VTAB);
            for (size_t i = (size_t)vcu * NTHR + tid; i < (size_t)16384 * 1024 / 8; i += (size_t)G * NTHR) {
                { const f32x4 a = *(const GAS f32x4*)(su + 8 * i), b = *(const GAS f32x4*)(su + 8 * i + 4); v4u o; o.x = pk2(a.x, a.y); o.y = pk2(a.z, a.w); o.z = pk2(b.x, b.y); o.w = pk2(b.z, b.w); *(GAS v4u*)(du + 8 * i) = o; }
                { const f32x4 a = *(const GAS f32x4*)(sv + 8 * i), b = *(const GAS f32x4*)(sv + 8 * i + 4); v4u o; o.x = pk2(a.x, a.y); o.y = pk2(a.z, a.w); o.z = pk2(b.x, b.y); o.w = pk2(b.z, b.w); *(GAS v4u*)(dv + 8 * i) = o; }
            }
        }
        SEAM(pb + 7);
        if (PHON(8) && IN(pb + 8)) { PHASE_IDS
            pg8::Gemm g{(const bf16*)(ws + WS_U), (const bf16*)(ws + WS_WQ), T, 2048, 1024, 1024, 1024}; pg8::StaticOrder S; S.init(T, 2048, G, bx);
            EpiScaleRow E{(bf16*)(ws + WS_QP), 2048, nullptr, 0}; pg8::gemm_phase(lds, g, S, E);
        }
        SEAM(pb + 8);
        if (PHON(9) && IN(pb + 9)) { PHASE_IDS
#ifdef DBG_NAIVE_ROUTE
            for (int u = vcu; u < (T / 512) * 8; u += G) peer_route_naive_unit(ws, lds, u >> 3, u & 7, tid);
#else
            for (int u = vcu; u < (T / 256) * 8; u += G) peer_route_unit(ws, lds, u >> 3, u & 7, wave, lane);
#endif
        }
        SEAM(pb + 9);
        if (PHON(10) && IN(pb + 10)) { PHASE_IDS
#ifdef DBG_NAIVE_GATHER
            for (int m = gw; m < T; m += NGW) peer_token_naive(ws, P.out, modl + (size_t)(m / SEQ) * 6144 + 5120, P.in[25] + l * 1024, P.in[26] + l * 1024, (size_t)m, lane);
#else
            for (int m = gw; m < T; m += NGW) peer_token(ws, P.out, modl + (size_t)(m / SEQ) * 6144 + 5120, P.in[25] + l * 1024, P.in[26] + l * 1024, (size_t)m, lane);
#endif
        }
        SEAM(pb + 10);
    }
#undef IN
#undef SEAM
}

extern "C" void kernel_launch(void* const* d_in, const int* in_sizes, int n_in, void* d_out, int out_size, void* d_ws, size_t ws_size, hipStream_t stream) {
    static int grid = 0;
    if (grid == 0) {
        if (n_in != 27 || out_size != T * DM || ws_size < WS_END) { fprintf(stderr, "kernel_launch: unexpected problem (n_in %d, out %d, ws %zu < %zu?)\n", n_in, out_size, ws_size, (size_t)WS_END); grid = -1; return; }
        int dev = 0, cus = 0, per_cu = 0;
        if (hipGetDevice(&dev) != hipSuccess || hipDeviceGetAttribute(&cus, hipDeviceAttributeMultiprocessorCount, dev) != hipSuccess) { grid = -1; return; }
        if (hipFuncSetAttribute((const void*)fwd_kernel, hipFuncAttributeMaxDynamicSharedMemorySize, LDS_BYTES) != hipSuccess) { fprintf(stderr, "kernel_launch: hipFuncSetAttribute failed\n"); grid = -1; return; }
        if (hipOccupancyMaxActiveBlocksPerMultiprocessor(&per_cu, (const void*)fwd_kernel, NTHR, LDS_BYTES) != hipSuccess || per_cu < 1) { fprintf(stderr, "kernel_launch: occupancy query says %d\n", per_cu); }
        (void)hipGetLastError();
        grid = cus;
        fprintf(stderr, "kernel_launch: grid %d, ws %zu MiB\n", grid, ws_size >> 20);
    }
    if (grid < 0) return;
    (void)hipMemsetAsync((char*)d_ws + WS_CTL, 0, CTL_ZERO_BYTES, stream);
    Args a{};
    for (int i = 0; i < 27; ++i) a.in[i] = (const float*)d_in[i];
    a.out = (float*)d_out; a.ws = (unsigned char*)d_ws;
    for (int i = 0; i < 32; ++i) a.inv64[i] = (float)pow(10000.0, -(double)(2 * i) / 64.0);
    for (int i = 0; i < 16; ++i) a.inv32[i] = (float)pow(10000.0, -(double)(2 * i) / 32.0);
#if MK_MULTI
    for (int k = 0; k < NPHASE; ++k) { a.ph_lo = k; a.ph_hi = k + 1; hipLaunchKernelGGL(fwd_kernel, dim3(grid), dim3(NTHR), LDS_BYTES, stream, a); }
#else
    a.ph_lo = 0; a.ph_hi = NPHASE; hipLaunchKernelGGL(fwd_kernel, dim3(grid), dim3(NTHR), LDS_BYTES, stream, a);
#endif
}
```

```cpp
#include <hip/hip_runtime.h>
#include <cstdio>
#include <cstdint>
#include <cmath>

namespace pg8 {
#define PG8_LAS __attribute__((address_space(3)))
typedef unsigned short bf16_t;
typedef short bf16x8 __attribute__((ext_vector_type(8)));
typedef float f32x4 __attribute__((ext_vector_type(4)));
typedef unsigned u32x4 __attribute__((ext_vector_type(4)));
typedef long i64x2 __attribute__((ext_vector_type(2)));
typedef int i32x4 __attribute__((ext_vector_type(4)));
typedef int i32x8 __attribute__((ext_vector_type(8)));
constexpr int BM = 256, BK = 64, HALF = 128, HTB = HALF * BK * 2  , STAGE_BYTES = 8 * HTB, NXCD = 8, WGM = 8;

__host__ __device__ __forceinline__ int lds_byte(int r, int c) { const int st = (r >> 4) * 2 + (c >> 5), rr = r & 15, cc = c & 31, ob = rr * 64 + cc * 2; return st * 1024 + (ob ^ (((ob >> 9) & 1) << 5)); }
__host__ __device__ __forceinline__ void stage_rc(int b, int& R, int& C) { const int st = b / 1024, sb = b % 1024, swz = sb ^ (((sb >> 9) & 1) << 5); R = (st >> 1) * 16 + swz / 64; C = (st & 1) * 32 + (swz % 64) / 2; }
__host__ __device__ __forceinline__ int perm32(int rho) { const int n = rho >> 4, i = rho & 15; return 8 * (i >> 2) + 4 * n + (i & 3); }

struct Unit { int pm, pn; };
struct Gemm { const bf16_t* A; const bf16_t* Bt; int M, N, K, lda, ldb; };

struct StaticOrder {
    int nM, nN, nwg, G, c;
    __host__ __device__ void init(int M, int N, int G_, int c_) { nM = M / BM; nN = N / BM; nwg = nM * nN; G = G_; c = c_; }
    __host__ __device__ bool next(int i, Unit& u) const {
        const long L = (long)i * G + c; if (L >= nwg) return false;
        int wgid = (int)L; { const int q = nwg / NXCD, r = nwg % NXCD, xcd = wgid % NXCD, off = wgid / NXCD; wgid = (xcd < r ? xcd * (q + 1) : r * (q + 1) + (xcd - r) * q) + off; }
        const int nig = WGM * nN, gid = wgid / nig, fm = gid * WGM, gsz = (nM - fm) < WGM ? (nM - fm) : WGM;
        u.pm = fm + ((wgid % nig) % gsz); u.pn = (wgid % nig) / gsz; return true;
    }
};

__device__ __forceinline__ unsigned cvt_pk_bf16(float lo, float hi) { unsigned r; asm volatile("v_cvt_pk_bf16_f32 %0, %1, %2" : "=v"(r) : "v"(lo), "v"(hi)); return r; }

template <bool F8, class Epi, class Sched>
__device__ __forceinline__ void gemm_phase(PG8_LAS unsigned char* lds, const Gemm g, const Sched& S, Epi& E) {
    int tid = threadIdx.x; asm volatile("" : "+v"(tid));
    const int wid = __builtin_amdgcn_readfirstlane(tid >> 6), lane = tid & 63, wr = wid >> 2, wc = wid & 3, fr = lane & 15, fq = lane >> 4;
    const int K = g.K, nt = K / BK;
    unsigned voffA[2], voffB[2];
#pragma unroll
    for (int i = 0; i < 2; ++i) { int R, C; stage_rc(tid * 16 + i * 8192, R, C); const int Rb = (R & ~31) + perm32(R & 31);
        voffA[i] = (unsigned)(R * g.lda + C) * 2u; voffB[i] = (unsigned)(Rb * g.ldb + C) * 2u; }
    const size_t kstep = (size_t)(BK * 2);
    const size_t hstepA = (size_t)HALF * g.lda * 2, hstepB = (size_t)HALF * g.ldb * 2;
    const size_t tstepA = 2 * hstepA, tstepB = 2 * hstepB;
    const unsigned ldsw = (unsigned)wid * 1024u;
    const int aoff = lds_byte(wr * 64 + fr, fq * 8), boff = lds_byte(wc * 32 + fr, fq * 8);
#define PG8_SA(b, h) (((b) * 2 + (h)) * HTB)
#define PG8_SB(b, h) ((4 + (b) * 2 + (h)) * HTB)
#define PG8_STAGE(bufoff, gbase, voff) do { _Pragma("unroll") for (int _i = 0; _i < 2; ++_i) \
        __builtin_amdgcn_global_load_lds((const unsigned*)((const char*)(gbase) + (voff)[_i]), (PG8_LAS unsigned*)(lds + (bufoff) + ldsw + _i * 8192), 16, 0, 0); } while (0)
#define PG8_LDA(dst, b, h) do { _Pragma("unroll") for (int m = 0; m < 4; ++m) _Pragma("unroll") for (int k = 0; k < 2; ++k) dst[m][k] = *(const PG8_LAS bf16x8*)(lds + PG8_SA(b, h) + aoff + m * 2048 + k * 1024); } while (0)
#define PG8_LDB(dst, b, h) do { _Pragma("unroll") for (int n = 0; n < 2; ++n) _Pragma("unroll") for (int k = 0; k < 2; ++k) dst[n][k] = *(const PG8_LAS bf16x8*)(lds + PG8_SB(b, h) + boff + n * 2048 + k * 1024); } while (0)
#define PG8_MMA(ai, bj, At, Bt) do { __builtin_amdgcn_s_setprio(1); _Pragma("unroll") for (int m = 0; m < 4; ++m) _Pragma("unroll") for (int n = 0; n < 2; ++n) _Pragma("unroll") for (int k = 0; k < 2; ++k) { \
        if constexpr (F8) { if (k == 0) { const i32x4 b0_ = __builtin_bit_cast(i32x4, Bt[n][0]), b1_ = __builtin_bit_cast(i32x4, Bt[n][1]), a0_ = __builtin_bit_cast(i32x4, At[m][0]), a1_ = __builtin_bit_cast(i32x4, At[m][1]); \
            const i32x8 bb_ = {b0_.x, b0_.y, b0_.z, b0_.w, b1_.x, b1_.y, b1_.z, b1_.w}, aa_ = {a0_.x, a0_.y, a0_.z, a0_.w, a1_.x, a1_.y, a1_.z, a1_.w}; \
            asm volatile("v_mfma_scale_f32_16x16x128_f8f6f4 %0, %1, %2, %0, %3, %3 op_sel_hi:[0,0,0]" : "+v"(acc[ai][bj][m][n]) : "v"(bb_), "v"(aa_), "v"(0x7F7F7F7F)); } } \
        else acc[ai][bj][m][n] = __builtin_amdgcn_mfma_f32_16x16x32_bf16(Bt[n][k], At[m][k], acc[ai][bj][m][n], 0, 0, 0); } \
        __builtin_amdgcn_s_setprio(0); } while (0)
#define PG8_WAIT_V(n) asm volatile("s_waitcnt vmcnt(" #n ")" ::: "memory")
#define PG8_WAIT_L(n) asm volatile("s_waitcnt lgkmcnt(" #n ")" ::: "memory")
#define PG8_BAR __builtin_amdgcn_s_barrier()
#define PG8_SCHED __builtin_amdgcn_sched_barrier(0)
    Unit cur, nxt; int ui = 0;
    if (!S.next(0, cur)) return;
    f32x4 acc[2][2][4][2];
#pragma unroll
    for (int a = 0; a < 2; ++a)
#pragma unroll
        for (int b = 0; b < 2; ++b)
#pragma unroll
            for (int m = 0; m < 4; ++m)
#pragma unroll
                for (int n = 0; n < 2; ++n) acc[a][b][m][n] = (f32x4){0.f, 0.f, 0.f, 0.f};
    bf16x8 At[4][2], B0[2][2], B1[2][2];
    const char* cA = (const char*)g.A + (size_t)cur.pm * tstepA; const char* cB = (const char*)g.Bt + (size_t)cur.pn * tstepB;
    PG8_STAGE(PG8_SB(0, 0), cB, voffB); PG8_STAGE(PG8_SB(0, 1), cB + hstepB, voffB); PG8_STAGE(PG8_SA(0, 0), cA, voffA); PG8_STAGE(PG8_SA(0, 1), cA + hstepA, voffA);
    if (wr == 1) PG8_BAR;
    PG8_WAIT_V(2); PG8_BAR;
    PG8_STAGE(PG8_SB(1, 0), cB + kstep, voffB); PG8_STAGE(PG8_SA(1, 0), cA + kstep, voffA); PG8_STAGE(PG8_SB(1, 1), cB + hstepB + kstep, voffB);
    PG8_WAIT_V(6); PG8_BAR;
    for (;;) {
        const bool has_next = S.next(ui + 1, nxt);
        const char* nA = has_next ? (const char*)g.A + (size_t)nxt.pm * tstepA : cA; const char* nB = has_next ? (const char*)g.Bt + (size_t)nxt.pn * tstepB : cB;
#pragma unroll 1
        for (int t = 0; t < nt; t += 2) {
            const bool last = (t == nt - 2);
            const char* a1 = cA + (size_t)(t + 1) * kstep;
            const char* a2 = last ? nA : cA + (size_t)(t + 2) * kstep; const char* b2 = last ? nB : cB + (size_t)(t + 2) * kstep;
            const char* a3 = a2 + kstep; const char* b3 = b2 + kstep;
            PG8_LDB(B0, 0, 0); PG8_LDB(B1, 0, 1); PG8_SCHED; PG8_LDA(At, 0, 0); PG8_STAGE(PG8_SA(1, 1), a1 + hstepA, voffA);
            PG8_WAIT_V(8); PG8_WAIT_L(0); PG8_BAR; PG8_MMA(0, 0, At, B0); PG8_MMA(0, 1, At, B1); PG8_BAR; PG8_SCHED;
            PG8_LDA(At, 0, 1); PG8_STAGE(PG8_SB(0, 0), b2, voffB); PG8_STAGE(PG8_SB(0, 1), b2 + hstepB, voffB); PG8_STAGE(PG8_SA(0, 0), a2, voffA);
            PG8_WAIT_V(8); PG8_WAIT_L(0); PG8_BAR; PG8_MMA(1, 0, At, B0); PG8_MMA(1, 1, At, B1); PG8_BAR; PG8_SCHED;
            PG8_LDB(B0, 1, 0); PG8_LDB(B1, 1, 1); PG8_SCHED; PG8_LDA(At, 1, 0); PG8_STAGE(PG8_SA(0, 1), a2 + hstepA, voffA);
            PG8_WAIT_V(8); PG8_WAIT_L(0); PG8_BAR; PG8_MMA(0, 0, At, B0); PG8_MMA(0, 1, At, B1); PG8_BAR; PG8_SCHED;
            PG8_LDA(At, 1, 1); PG8_STAGE(PG8_SB(1, 0), b3, voffB); PG8_STAGE(PG8_SB(1, 1), b3 + hstepB, voffB); PG8_STAGE(PG8_SA(1, 0), a3, voffA);
            PG8_WAIT_V(8); PG8_WAIT_L(0); PG8_BAR; PG8_MMA(1, 0, At, B0); PG8_MMA(1, 1, At, B1); PG8_BAR; PG8_SCHED;
        }
        if (wr == 0) PG8_BAR;
        if constexpr (F8) asm volatile("s_nop 7\n\ts_nop 7\n\ts_nop 7" ::: "memory");
        E(acc, cur, wr, wc, fr, fq);
        if (!has_next) break;
#pragma unroll
        for (int a = 0; a < 2; ++a)
#pragma unroll
            for (int b = 0; b < 2; ++b)
#pragma unroll
                for (int m = 0; m < 4; ++m)
#pragma unroll
                    for (int n = 0; n < 2; ++n) acc[a][b][m][n] = (f32x4){0.f, 0.f, 0.f, 0.f};
        cur = nxt; cA = nA; cB = nB; ++ui;
        if (wr == 1) PG8_BAR;
    }
    PG8_WAIT_V(0);
    PG8_BAR;
#undef PG8_SA
#undef PG8_SB
#undef PG8_STAGE
#undef PG8_LDA
#undef PG8_LDB
#undef PG8_MMA
#undef PG8_WAIT_V
#undef PG8_WAIT_L
#undef PG8_BAR
#undef PG8_SCHED
}
}

constexpr int BATCH = 4, SEQ = 8192, T = BATCH * SEQ, DM = 1024, DEPTH = 2;
constexpr int NWAVES = 8, NTHR = 512;
constexpr float LN_EPS = 1e-5f;
constexpr float DN_ALPHA = 1.4142135623730951f;
constexpr float LOG2E = 1.4426950408889634f;
constexpr int D_IN = 4512, NIN = 4608;
constexpr float C_D64 = 0.125f * LOG2E;
constexpr float C_MLA = 0.10206207261596577f * LOG2E;
constexpr int NPHASE = 1 + 11 * DEPTH;

constexpr size_t MiB = 1u << 20;
constexpr size_t WS_CTL = 0, CTL_ZERO_BYTES = 1 * MiB;
constexpr size_t WS_MOD = 1 * MiB;
constexpr size_t WS_ROPE64 = 2 * MiB;
constexpr size_t WS_ROPE32 = 4 * MiB;
constexpr size_t WS_RSTD = 5 * MiB;
constexpr size_t WS_WIN = 6 * MiB;
constexpr size_t WS_WG = 15 * MiB;
constexpr size_t WS_WB = 23 * MiB;
constexpr size_t WS_WO = 27 * MiB;
constexpr size_t WS_WQ = 29 * MiB;
constexpr size_t WS_QUP = 33 * MiB;
constexpr size_t WS_KVUP = 34 * MiB;
constexpr size_t WS_KEYS = 35 * MiB;
constexpr size_t WS_U = 36 * MiB;
constexpr size_t WS_SWAQ = 100 * MiB;
constexpr size_t WS_SWAKV = 132 * MiB;
constexpr size_t WS_LAT = 148 * MiB;
constexpr size_t WS_DIFQ = 196 * MiB;
constexpr size_t WS_DIFK = 228 * MiB;
constexpr size_t WS_DIFV = 260 * MiB;
constexpr size_t WS_NATQ = 292 * MiB;
constexpr size_t WS_NATK = 324 * MiB;
constexpr size_t WS_NATV = 356 * MiB;
constexpr size_t WS_MQN = 388 * MiB;
constexpr size_t WS_MQR = 420 * MiB;
constexpr size_t WS_KVB = 436 * MiB;
constexpr size_t WS_DSCR = 500 * MiB;
constexpr size_t WS_END = 516 * MiB;
constexpr size_t WS_SG = WS_NATK;
constexpr size_t WS_MERGED = WS_DIFK;
constexpr size_t WS_U2 = WS_DIFK;
constexpr size_t WS_QP = WS_SWAQ;
constexpr size_t WS_PIDX = WS_NATQ;
constexpr size_t WS_PGATE = WS_NATQ + 16 * MiB;
constexpr size_t WS_UTAB = WS_KVB;
constexpr size_t WS_VTAB = WS_KVB + 32 * MiB;
constexpr size_t WS_TSCALE = WS_KVB + 63 * MiB;
constexpr int CW_BAR = 4096;

constexpr int RING_BYTES = 131072;
constexpr int LDSCTL_OFF = RING_BYTES, MISC_OFF = LDSCTL_OFF + 320;
constexpr int LDS_BYTES = 147456;
constexpr float U8_SCALE = 4.f, W8_SCALE = 64.f, UW8_INV = 1.f / (U8_SCALE * W8_SCALE);
constexpr float O8_SCALE = 16.f;
#define GAS __attribute__((address_space(1)))
#define LAS __attribute__((address_space(3)))
typedef unsigned short bf16;
typedef unsigned v4u __attribute__((ext_vector_type(4)));
typedef float f32x4 __attribute__((ext_vector_type(4)));
typedef short bf16x8 __attribute__((ext_vector_type(8)));
typedef GAS unsigned gu32;
typedef GAS unsigned long long gu64;
#define RLX_AGENT __ATOMIC_RELAXED, __HIP_MEMORY_SCOPE_AGENT
#define LDS_WAIT() asm volatile("s_waitcnt lgkmcnt(0)" ::: "memory")
#define VM_WAIT() asm volatile("s_waitcnt vmcnt(0)" ::: "memory")
__device__ __forceinline__ unsigned long long rt() { return __builtin_amdgcn_s_memrealtime(); }
__device__ __forceinline__ unsigned f2bf(float f) { unsigned u = __builtin_bit_cast(unsigned, f); return (u + 0x7fffu + ((u >> 16) & 1u)) >> 16; }
__device__ __forceinline__ unsigned pk2(float lo, float hi) { return f2bf(lo) | (f2bf(hi) << 16); }

#define XB_TMO      128
#define XB_XCNT(j)  (256  + 64 * (j))
#define XB_XSUB(j)  (1280 + 64 * (j))
#define XB_XGEN(j)  (2304 + 64 * (j))
#define XB_TOP      3328
#define XB_TOPGEN   3392
#define XCD_BAR_WORDS 3456
#define XB_SPIN_CAP (1u << 18)

__device__ __forceinline__ unsigned xb_ld(unsigned* p)              { return __hip_atomic_load(p, __ATOMIC_RELAXED, __HIP_MEMORY_SCOPE_AGENT); }
__device__ __forceinline__ unsigned xb_add(unsigned* p, unsigned v) { return __hip_atomic_fetch_add(p, v, __ATOMIC_RELAXED, __HIP_MEMORY_SCOPE_AGENT); }
__device__ __forceinline__ unsigned xb_xcc_id() { return (unsigned)__builtin_amdgcn_s_getreg((3 << 11) | 20) & 0xFu; }
#define XB_SPIN(cond, bar) do { unsigned _sp = 0; while (cond) { __builtin_amdgcn_s_sleep(1); \
    if ((++_sp & 255u) == 0u) { if (xb_ld(&(bar)[XB_TMO])) break; if (_sp > XB_SPIN_CAP) { atomicAdd(&(bar)[XB_TMO], 1u); break; } } } } while (0)

struct XcdBarrier {
    unsigned* bar; unsigned x;
    volatile LAS unsigned* st;
};

__device__ __forceinline__ XcdBarrier xcd_barrier_post(unsigned* bar, volatile LAS unsigned* st) {
    XcdBarrier b; b.bar = bar; b.x = xb_xcc_id(); b.st = st;
    if (threadIdx.x == 0) (void)xb_add(&bar[XB_XCNT(b.x)], 1u);
    return b;
}
__device__ __forceinline__ void xcd_barrier_complete(unsigned* bar, unsigned x, unsigned& nloc, unsigned& nx) {
    const unsigned G = gridDim.x * gridDim.y * gridDim.z;
    unsigned sum, cnt, mine, sp = 0u;
    for (;;) {
        sum = 0u; cnt = 0u; mine = 0u;
#pragma unroll
        for (unsigned j = 0; j < 16; ++j) { const unsigned c = xb_ld(&bar[XB_XCNT(j)]); sum += c; cnt += (c > 0u) ? 1u : 0u; mine = (j == x) ? c : mine; }
        if (sum == G) break;
        __builtin_amdgcn_s_sleep(1);
        if ((++sp & 255u) == 0u) { if (xb_ld(&bar[XB_TMO])) break; if (sp > XB_SPIN_CAP) { atomicAdd(&bar[XB_TMO], 1u); break; } }
    }
    nloc = mine > 0u ? mine : 1u; nx = cnt > 0u ? cnt : 1u;
}

__device__ __forceinline__ void xcd_barrier(const XcdBarrier& b) {
    asm volatile("s_waitcnt vmcnt(0)" ::: "memory");
    __syncthreads();
    if (threadIdx.x == 0) {
        unsigned* bar = b.bar;
        __builtin_amdgcn_s_waitcnt(0);
        unsigned nloc = b.st[0], nx = b.st[1];
        if (nloc == 0u) { xcd_barrier_complete(bar, b.x, nloc, nx); b.st[0] = nloc; b.st[1] = nx; }
        const unsigned old = xb_add(&bar[XB_XSUB(b.x)], 1u);
        const unsigned gen = old / nloc;
        if (old + 1u == (gen + 1u) * nloc) {
            __builtin_amdgcn_fence(__ATOMIC_RELEASE, "agent");
            asm volatile("s_waitcnt vmcnt(0)" ::: "memory");
            const unsigned og = xb_add(&bar[XB_TOP], 1u);
            const unsigned tg = og / nx;
            if (og + 1u == (tg + 1u) * nx) xb_add(&bar[XB_TOPGEN], 1u);
            else XB_SPIN(xb_ld(&bar[XB_TOPGEN]) == tg, bar);
            __builtin_amdgcn_fence(__ATOMIC_ACQUIRE, "agent");
            xb_add(&bar[XB_XGEN(b.x)], 1u);
            asm volatile("s_waitcnt vmcnt(0)" ::: "memory");
        } else {
            XB_SPIN(xb_ld(&bar[XB_XGEN(b.x)]) == gen, bar);
            __builtin_amdgcn_fence(__ATOMIC_ACQUIRE, "agent");
            asm volatile("s_waitcnt vmcnt(0)" ::: "memory");
        }
    }
    __syncthreads();
}

typedef float f32x16 __attribute__((ext_vector_type(16)));
typedef float f32x2 __attribute__((ext_vector_type(2)));
typedef short s16x4 __attribute__((ext_vector_type(4)));
typedef __bf16 bf16x2_t __attribute__((ext_vector_type(2)));

#define WAVE_DPP_(v, ctrl) __builtin_bit_cast(float, __builtin_amdgcn_update_dpp(0, __builtin_bit_cast(int, v), ctrl, 0xF, 0xF, true))
__device__ __forceinline__ float wave_sum(float v) {
    v += WAVE_DPP_(v, 0xB1); v += WAVE_DPP_(v, 0x4E); v += WAVE_DPP_(v, 0x141); v += WAVE_DPP_(v, 0x140);
    { auto rr = __builtin_amdgcn_permlane16_swap(__float_as_uint(v), __float_as_uint(v), false, false); v = __uint_as_float(rr[0]) + __uint_as_float(rr[1]); }
    { auto rr = __builtin_amdgcn_permlane32_swap(__float_as_uint(v), __float_as_uint(v), false, false); v = __uint_as_float(rr[0]) + __uint_as_float(rr[1]); }
    return v;
}
__device__ __forceinline__ float wave_max(float v) {
    v = fmaxf(v, WAVE_DPP_(v, 0xB1)); v = fmaxf(v, WAVE_DPP_(v, 0x4E)); v = fmaxf(v, WAVE_DPP_(v, 0x141)); v = fmaxf(v, WAVE_DPP_(v, 0x140));
    { auto rr = __builtin_amdgcn_permlane16_swap(__float_as_uint(v), __float_as_uint(v), false, false); v = fmaxf(__uint_as_float(rr[0]), __uint_as_float(rr[1])); }
    { auto rr = __builtin_amdgcn_permlane32_swap(__float_as_uint(v), __float_as_uint(v), false, false); v = fmaxf(__uint_as_float(rr[0]), __uint_as_float(rr[1])); }
    return v;
}
__device__ __forceinline__ float shl_f(float v, int src) { return __int_as_float(__builtin_amdgcn_ds_bpermute(src << 2, __float_as_int(v))); }
__device__ __forceinline__ int shl_i(int v, int src) { return __builtin_amdgcn_ds_bpermute(src << 2, v); }
__device__ __forceinline__ float bf_lo(unsigned u) { return __builtin_bit_cast(float, u << 16); }
__device__ __forceinline__ float bf_hi(unsigned u) { return __builtin_bit_cast(float, u & 0xffff0000u); }
__device__ __forceinline__ unsigned cvtpk(float lo, float hi) { f32x2 v = {lo, hi}; bf16x2_t b = __builtin_convertvector(v, bf16x2_t); return __builtin_bit_cast(unsigned, b); }
__device__ __forceinline__ float fast_exp2(float x) { return __builtin_amdgcn_exp2f(x); }
__device__ __forceinline__ float fast_rcp(float x) { return __builtin_amdgcn_rcpf(x); }
__device__ __forceinline__ float halves_max(float m) { auto rr = __builtin_amdgcn_permlane32_swap(__float_as_uint(m), __float_as_uint(m), false, false); return fmaxf(__uint_as_float(rr[0]), __uint_as_float(rr[1])); }
__device__ __forceinline__ float halves_sum(float m) { auto rr = __builtin_amdgcn_permlane32_swap(__float_as_uint(m), __float_as_uint(m), false, false); return __uint_as_float(rr[0]) + __uint_as_float(rr[1]); }
__device__ __forceinline__ unsigned halves_umax(unsigned m) { auto rr = __builtin_amdgcn_permlane32_swap(m, m, false, false); return rr[0] > rr[1] ? rr[0] : rr[1]; }

__device__ __forceinline__ int rope64_src(int j) { return (j & 1) ? (j >> 1) + 32 : (j >> 1); }
__device__ __forceinline__ int rope32_src(int j) { return (j & 1) ? (j >> 1) + 16 : (j >> 1); }
struct MapId { __device__ __forceinline__ int operator()(int n) const { return n; } };
struct MapIn { __device__ __forceinline__ int operator()(int n) const {
    if (n < 640) return (n & ~63) + rope64_src(n & 63);
    if (n < 768) return n;
    if (n < 1536) { const int m = n - 768; if (m < 640) return 768 + m; if (m < 672) return 1408 + rope32_src(m - 640); return -1; }
    if (n < 2560) { const int m = n - 1536; return 1440 + (m & ~63) + rope64_src(m & 63); }
    return 2464 + (n - 2560);
} };
struct MapQup { __device__ __forceinline__ int operator()(int n) const { if (n < 512) return (n >> 6) * 96 + (n & 63); const int m = n - 512; return (m >> 5) * 96 + 64 + rope32_src(m & 31); } };
struct MapKvup { __device__ __forceinline__ int operator()(int n) const { if (n < 512) return (n >> 6) * 128 + (n & 63); const int m = n - 512; return (m >> 6) * 128 + 64 + (m & 63); } };

template <class Map>
__device__ __forceinline__ void conv_item(const float* __restrict__ W, int ldw, const float* __restrict__ kscale, int K, bf16* WT, int n0, int k0, const Map& map, LAS float* scr, int lane, float f8 = 0.f  ) {
    const int nn = lane & 31; const int src = map(n0 + nn);
    float v[32];
#pragma unroll
    for (int i = 0; i < 32; ++i) { const int kk = 2 * i + (lane >> 5); v[i] = (src >= 0) ? W[(size_t)(k0 + kk) * ldw + src] : 0.f; }
#pragma unroll
    for (int i = 0; i < 32; ++i) { const int kk = 2 * i + (lane >> 5); float x = v[i];
        if (kscale) x *= kscale[k0 + kk];
        scr[kk * 33 + nn] = x; }
    LDS_WAIT(); asm volatile("" ::: "memory");
    const int c = lane & 7;
#pragma unroll
    for (int j = 0; j < 4; ++j) { const int n = (lane >> 3) + 8 * j; const LAS float* s = scr + (8 * c) * 33 + n;
        if (f8 != 0.f) { float y[8];
#pragma unroll
            for (int e = 0; e < 8; ++e) y[e] = __builtin_amdgcn_fmed3f(s[e * 33] * f8, -440.f, 440.f);
            int lo = __builtin_amdgcn_cvt_pk_fp8_f32(y[0], y[1], 0, false); lo = __builtin_amdgcn_cvt_pk_fp8_f32(y[2], y[3], lo, true);
            int hi2 = __builtin_amdgcn_cvt_pk_fp8_f32(y[4], y[5], 0, false); hi2 = __builtin_amdgcn_cvt_pk_fp8_f32(y[6], y[7], hi2, true);
            *(GAS unsigned long long*)((unsigned char*)WT + (size_t)(n0 + n) * K + k0 + 8 * c) = (unsigned long long)(unsigned)lo | ((unsigned long long)(unsigned)hi2 << 32); }
        else { v4u o; o.x = pk2(s[0 * 33], s[1 * 33]); o.y = pk2(s[2 * 33], s[3 * 33]); o.z = pk2(s[4 * 33], s[5 * 33]); o.w = pk2(s[6 * 33], s[7 * 33]);
            *(GAS v4u*)(WT + (size_t)(n0 + n) * K + k0 + 8 * c) = o; } }
    LDS_WAIT(); asm volatile("" ::: "memory");
}

struct Ptrs {
    const float* in[27]; float* out; unsigned char* ws;
};

__device__ __forceinline__ void convert_weights(const Ptrs& P, int l, LAS unsigned char* lds, int gw, int NGW, int wave, int lane) {
    LAS float* scr = (LAS float*)(lds + wave * 16384);
    unsigned char* ws = P.ws;
    constexpr int I_IN = 16 * 144, I_G = 16 * 32, I_B = 8 * 32, I_O = 16 * 32, I_Q = 16 * 64, I_QU = 6 * 24, I_KU = 4 * 32;
    constexpr int NIT = I_IN + 4 * I_G + 4 * I_B + I_O + I_Q + I_QU + I_KU;
    for (int it = gw; it < NIT; it += NGW) {
        int r = it;
        if (r < I_IN) { conv_item(P.in[4] + (size_t)l * 1024 * D_IN, D_IN, nullptr, 1024, (bf16*)(ws + WS_WIN), 32 * (r % 144), 64 * (r / 144), MapIn(), scr, lane, W8_SCALE); continue; } r -= I_IN;
        if (r < 4 * I_G) { const int n = r / I_G, q = r % I_G; conv_item(P.in[16] + ((size_t)l * 4 + n) * 1024 * 1024, 1024, nullptr, 1024, (bf16*)(ws + WS_WG + (size_t)n * 1024 * 1024), 32 * (q % 32), 64 * (q / 32), MapId(), scr, lane, W8_SCALE); continue; } r -= 4 * I_G;
        if (r < 4 * I_B) { const int n = r / I_B, q = r % I_B; conv_item(P.in[17] + ((size_t)l * 4 + n) * 512 * 1024, 1024, nullptr, 512, (bf16*)(ws + WS_WB + (size_t)n * 1024 * 512), 32 * (q % 32), 64 * (q / 32), MapId(), scr, lane, W8_SCALE); continue; } r -= 4 * I_B;
        if (r < I_O) { conv_item(P.in[18] + (size_t)l * 1024 * 1024, 1024, nullptr, 1024, (bf16*)(ws + WS_WO), 32 * (r % 32), 64 * (r / 32), MapId(), scr, lane, W8_SCALE); continue; } r -= I_O;
        if (r < I_Q) { conv_item(P.in[21] + (size_t)l * 1024 * 2048, 2048, nullptr, 1024, (bf16*)(ws + WS_WQ), 32 * (r % 64), 64 * (r / 64), MapId(), scr, lane); continue; } r -= I_Q;
        if (r < I_QU) { conv_item(P.in[7] + (size_t)l * 384 * 768, 768, P.in[6] + l * 384, 384, (bf16*)(ws + WS_QUP), 32 * (r % 24), 64 * (r / 24), MapQup(), scr, lane); continue; } r -= I_QU;
        conv_item(P.in[9] + (size_t)l * 256 * 1024, 1024, P.in[8] + l * 256, 256, (bf16*)(ws + WS_KVUP), 32 * (r % 32), 64 * (r / 32), MapKvup(), scr, lane);
    }
    const float* ks = P.in[22] + (size_t)l * 262144; bf16* kd = (bf16*)(ws + WS_KEYS);
    for (int i = gw * 64 + lane; i < 262144 / 8; i += NGW * 64) {
        const f32x4 a = *(const GAS f32x4*)(ks + 8 * i), b = *(const GAS f32x4*)(ks + 8 * i + 4);
        v4u o; o.x = pk2(a.x, a.y); o.y = pk2(a.z, a.w); o.z = pk2(b.x, b.y); o.w = pk2(b.z, b.w);
        *(GAS v4u*)(kd + 8 * i) = o; }
}

__device__ __forceinline__ void compute_mod(const Ptrs& P, LAS unsigned char* lds, int tid) {
    LAS float* sc = (LAS float*)lds; LAS float* red = (LAS float*)(lds + 16384);
    for (int i = tid; i < 4096; i += NTHR) { const float c = P.in[1][i]; sc[i] = c / (1.f + __expf(-c)); }
    __syncthreads();
    float* mod = (float*)(P.ws + WS_MOD);
    for (int item = blockIdx.x; item < 96; item += gridDim.x) {
        const int l = item / 48, cb = item % 48, cl = tid & 127, kg = tid >> 7, col = cb * 128 + cl;
        const float* w = P.in[2] + ((size_t)l * 1024 + kg * 256) * 6144 + col;
        float a0 = 0.f, a1 = 0.f, a2 = 0.f, a3 = 0.f;
#pragma unroll 16
        for (int k = 0; k < 256; ++k) { const float wv = w[(size_t)k * 6144]; const int kk = kg * 256 + k;
            a0 += sc[kk] * wv; a1 += sc[1024 + kk] * wv; a2 += sc[2048 + kk] * wv; a3 += sc[3072 + kk] * wv; }
        red[(kg * 4 + 0) * 128 + cl] = a0; red[(kg * 4 + 1) * 128 + cl] = a1; red[(kg * 4 + 2) * 128 + cl] = a2; red[(kg * 4 + 3) * 128 + cl] = a3;
        __syncthreads();
        { const int b = tid >> 7; const float s = red[(0 * 4 + b) * 128 + cl] + red[(1 * 4 + b) * 128 + cl] + red[(2 * 4 + b) * 128 + cl] + red[(3 * 4 + b) * 128 + cl];
          mod[((size_t)l * 4 + b) * 6144 + col] = s + P.in[3][l * 6144 + col]; }
        __syncthreads();
    }
}

__device__ __forceinline__ void compute_rope(const Ptrs& P, const float* inv64, const float* inv32, int gtid, int nthr) {
    f32x2* r64 = (f32x2*)(P.ws + WS_ROPE64); f32x2* r32 = (f32x2*)(P.ws + WS_ROPE32);
    for (int i = gtid; i < SEQ * 48; i += nthr) {
        const bool big = i < SEQ * 32; const int j = big ? i : i - SEQ * 32; const int pos = big ? (j >> 5) : (j >> 4); const int f = big ? (j & 31) : (j & 15);
        const float ang = (float)pos * (big ? inv64[f] : inv32[f]);
        double tr = (double)ang * 0.15915494309189535; tr -= rint(tr); const float fr = (float)tr;
        f32x2 cs; cs.x = __builtin_amdgcn_cosf(fr); cs.y = __builtin_amdgcn_sinf(fr);
        if (big) r64[j] = cs; else r32[j] = cs; }
}

__device__ __forceinline__ void load_row(f32x4 (&v)[4], const float* xrow, int lane) {
    const GAS f32x4* xr = (const GAS f32x4*)xrow + lane;
#pragma unroll
    for (int j = 0; j < 4; ++j) v[j] = xr[64 * j];
}
__device__ __forceinline__ void ln_mod_row(f32x4 (&v)[4], const float* sh, const float* sc, unsigned char* orow  , int lane) {
    float s = 0.f;
#pragma unroll
    for (int j = 0; j < 4; ++j) s += (v[j].x + v[j].y) + (v[j].z + v[j].w);
    const float mean = wave_sum(s) * (1.f / DM); float s2 = 0.f;
#pragma unroll
    for (int j = 0; j < 4; ++j) { v[j] = v[j] - mean; s2 += (v[j].x * v[j].x + v[j].y * v[j].y) + (v[j].z * v[j].z + v[j].w * v[j].w); }
    const float rstd = 1.f / sqrtf(wave_sum(s2) * (1.f / DM) + LN_EPS);
    GAS int* o4 = (GAS int*)orow + lane;
#pragma unroll
    for (int j = 0; j < 4; ++j) { const f32x4 a = ((const GAS f32x4*)sc)[lane + 64 * j], b = ((const GAS f32x4*)sh)[lane + 64 * j];
        f32x4 y = (v[j] * rstd * (a + 1.f) + b) * U8_SCALE; y.x = __builtin_amdgcn_fmed3f(y.x, -440.f, 440.f); y.y = __builtin_amdgcn_fmed3f(y.y, -440.f, 440.f); y.z = __builtin_amdgcn_fmed3f(y.z, -440.f, 440.f); y.w = __builtin_amdgcn_fmed3f(y.w, -440.f, 440.f);
        int wd = __builtin_amdgcn_cvt_pk_fp8_f32(y.x, y.y, 0, false); wd = __builtin_amdgcn_cvt_pk_fp8_f32(y.z, y.w, wd, true); o4[64 * j] = wd; }
}

#define EPI_ROWS_BEGIN \
    _Pragma("unroll") for (int ai = 0; ai < 2; ++ai) _Pragma("unroll") for (int m = 0; m < 4; ++m) { const int row = u.pm * 256 + ai * 128 + wr * 64 + m * 16 + fr;
#define EPI_ROWS_END }
__device__ __forceinline__ void store8(bf16* p, const float (&x)[8]) { v4u w; w.x = cvtpk(x[0], x[1]); w.y = cvtpk(x[2], x[3]); w.z = cvtpk(x[4], x[5]); w.w = cvtpk(x[6], x[7]); *(GAS v4u*)p = w; }
__device__ __forceinline__ void rope4(float (&x)[8], const f32x2* tab) {
    const f32x4 t0 = *(const GAS f32x4*)tab, t1 = *(const GAS f32x4*)(tab + 2);
    const float c[4] = {t0.x, t0.z, t1.x, t1.z}, s[4] = {t0.y, t0.w, t1.y, t1.w};
#pragma unroll
    for (int k = 0; k < 4; ++k) { const float a = x[2 * k], b = x[2 * k + 1]; x[2 * k] = a * c[k] - b * s[k]; x[2 * k + 1] = a * s[k] + b * c[k]; }
}

struct EpiInProj {
    unsigned char* ws;
    __device__ __forceinline__ void operator()(const pg8::f32x4 (&acc)[2][2][4][2], const pg8::Unit& u, int wr, int wc, int fr, int fq) {
        const int pn = u.pn; size_t boff; int pitch, lc0, mode0, mode1;
        if (pn < 2) { boff = WS_SWAQ; pitch = 512; lc0 = pn * 256; mode0 = mode1 = 2; }
        else if (pn == 2) { boff = WS_SWAKV; pitch = 256; lc0 = 0; mode0 = 1; mode1 = 0; }
        else if (pn < 6) { boff = WS_LAT; pitch = 768; lc0 = (pn - 3) * 256; mode0 = 0; mode1 = (pn == 5) ? 4 : 0; }
        else { const int q = (pn - 6) >> 1; boff = WS_DIFQ + (size_t)q * 32 * MiB; pitch = 512; lc0 = ((pn - 6) & 1) * 256; mode0 = mode1 = (q == 0) ? 2 : (q == 1) ? 1 : (q == 3) ? 3 : 0; }
        bf16* base = (bf16*)(ws + boff);
        const f32x2* r64 = (const f32x2*)(ws + WS_ROPE64); const f32x2* r32 = (const f32x2*)(ws + WS_ROPE32);
        if (pn >= 10 && pn < 12) {
#pragma unroll
            for (int ai = 0; ai < 2; ++ai) { const int row0 = u.pm * 256 + ai * 128 + wr * 64; const int bb = row0 >> 13, s0 = row0 & (SEQ - 1);
#pragma unroll
                for (int bj = 0; bj < 2; ++bj) { const int col = (pn - 10) * 256 + bj * 128 + wc * 32 + fq * 8;
#pragma unroll
                    for (int k = 0; k < 8; ++k) {
                        int wd = __builtin_amdgcn_cvt_pk_fp8_f32(acc[ai][bj][0][k >> 2][k & 3] * UW8_INV, acc[ai][bj][1][k >> 2][k & 3] * UW8_INV, 0, false);
                        wd = __builtin_amdgcn_cvt_pk_fp8_f32(acc[ai][bj][2][k >> 2][k & 3] * UW8_INV, acc[ai][bj][3][k >> 2][k & 3] * UW8_INV, wd, true);
                        *(GAS int*)(ws + WS_DIFV + ((size_t)(bb * 512 + col + k) << 13) + s0 + 4 * fr) = wd; } } }
            return; }
        EPI_ROWS_BEGIN
            const int pos = row & (SEQ - 1);
#pragma unroll
            for (int bj = 0; bj < 2; ++bj) {
                const int mode = bj ? mode1 : mode0; const int lcol = lc0 + bj * 128 + wc * 32 + fq * 8;
                float x[8] = {acc[ai][bj][m][0][0], acc[ai][bj][m][0][1], acc[ai][bj][m][0][2], acc[ai][bj][m][0][3], acc[ai][bj][m][1][0], acc[ai][bj][m][1][1], acc[ai][bj][m][1][2], acc[ai][bj][m][1][3]};
#pragma unroll
                for (int k = 0; k < 8; ++k) x[k] *= UW8_INV;
                if (mode == 1 || mode == 2) rope4(x, r64 + pos * 32 + ((lcol & 63) >> 1));
                if (mode == 4 && lcol >= 640 && lcol < 672) rope4(x, r32 + pos * 16 + ((lcol - 640) >> 1));
                if (mode == 2 || mode == 3) {
#pragma unroll
                    for (int k = 0; k < 8; ++k) x[k] *= C_D64; }
                if (pn >= 8 && pn < 10) {
                    int lo = __builtin_amdgcn_cvt_pk_fp8_f32(x[0], x[1], 0, false); lo = __builtin_amdgcn_cvt_pk_fp8_f32(x[2], x[3], lo, true);
                    int hi2 = __builtin_amdgcn_cvt_pk_fp8_f32(x[4], x[5], 0, false); hi2 = __builtin_amdgcn_cvt_pk_fp8_f32(x[6], x[7], hi2, true);
                    *(GAS unsigned long long*)(ws + WS_DIFK + (size_t)row * 512 + lcol) = (unsigned long long)(unsigned)lo | ((unsigned long long)(unsigned)hi2 << 32); }
                else store8(base + (size_t)row * pitch + lcol, x);
            }
        EPI_ROWS_END
    }
};
struct EpiQup {
    unsigned char* ws;
    __device__ __forceinline__ void operator()(const pg8::f32x4 (&acc)[2][2][4][2], const pg8::Unit& u, int wr, int wc, int fr, int fq) {
        const int pn = u.pn; const float* rstd = (const float*)(ws + WS_RSTD);
        bf16* base = (bf16*)(ws + (pn < 2 ? WS_MQN : WS_MQR)); const int pitch = pn < 2 ? 512 : 256, lc0 = pn < 2 ? pn * 256 : 0;
        EPI_ROWS_BEGIN
            const float sc = rstd[2 * row] * C_MLA;
#pragma unroll
            for (int bj = 0; bj < 2; ++bj) {
                const int lcol = lc0 + bj * 128 + wc * 32 + fq * 8;
                float x[8] = {acc[ai][bj][m][0][0], acc[ai][bj][m][0][1], acc[ai][bj][m][0][2], acc[ai][bj][m][0][3], acc[ai][bj][m][1][0], acc[ai][bj][m][1][1], acc[ai][bj][m][1][2], acc[ai][bj][m][1][3]};
#pragma unroll
                for (int k = 0; k < 8; ++k) x[k] *= sc;
                store8(base + (size_t)row * pitch + lcol, x);
            }
        EPI_ROWS_END
    }
};
struct EpiScaleRow {
    bf16* O; int ldc; const float* rowscale; int rs_stride; int k8cols = 0;
    unsigned char* vt = nullptr;
    __device__ __forceinline__ void operator()(const pg8::f32x4 (&acc)[2][2][4][2], const pg8::Unit& u, int wr, int wc, int fr, int fq) {
        if (vt != nullptr && u.pn >= 2) {
#pragma unroll
            for (int ai = 0; ai < 2; ++ai) { const int row0 = u.pm * 256 + ai * 128 + wr * 64; const int bb = row0 >> 13, s0 = row0 & (SEQ - 1);
                const float s0_ = rowscale[(size_t)(row0 + fr) * rs_stride], s1_ = rowscale[(size_t)(row0 + 16 + fr) * rs_stride], s2_ = rowscale[(size_t)(row0 + 32 + fr) * rs_stride], s3_ = rowscale[(size_t)(row0 + 48 + fr) * rs_stride];
#pragma unroll
                for (int bj = 0; bj < 2; ++bj) { const int col = (u.pn - 2) * 256 + bj * 128 + wc * 32 + fq * 8;
#pragma unroll
                    for (int k = 0; k < 8; ++k) {
                        int wd = __builtin_amdgcn_cvt_pk_fp8_f32(acc[ai][bj][0][k >> 2][k & 3] * s0_, acc[ai][bj][1][k >> 2][k & 3] * s1_, 0, false);
                        wd = __builtin_amdgcn_cvt_pk_fp8_f32(acc[ai][bj][2][k >> 2][k & 3] * s2_, acc[ai][bj][3][k >> 2][k & 3] * s3_, wd, true);
                        *(GAS int*)(vt + ((size_t)(bb * 512 + col + k) << 13) + s0 + 4 * fr) = wd; } } }
            return; }
        EPI_ROWS_BEGIN
            const float sc = rowscale ? rowscale[(size_t)row * rs_stride] : 1.f;
#pragma unroll
            for (int bj = 0; bj < 2; ++bj) {
                const int col = u.pn * 256 + bj * 128 + wc * 32 + fq * 8;
                float x[8] = {acc[ai][bj][m][0][0], acc[ai][bj][m][0][1], acc[ai][bj][m][0][2], acc[ai][bj][m][0][3], acc[ai][bj][m][1][0], acc[ai][bj][m][1][1], acc[ai][bj][m][1][2], acc[ai][bj][m][1][3]};
#pragma unroll
                for (int k = 0; k < 8; ++k) x[k] *= sc;
                if (col < k8cols) { int lo = __builtin_amdgcn_cvt_pk_fp8_f32(x[0], x[1], 0, false); lo = __builtin_amdgcn_cvt_pk_fp8_f32(x[2], x[3], lo, true);
                    int hi2 = __builtin_amdgcn_cvt_pk_fp8_f32(x[4], x[5], 0, false); hi2 = __builtin_amdgcn_cvt_pk_fp8_f32(x[6], x[7], hi2, true);
                    *(GAS unsigned long long*)((unsigned char*)(O + (size_t)row * ldc) + col) = (unsigned long long)(unsigned)lo | ((unsigned long long)(unsigned)hi2 << 32); }
                else store8(O + (size_t)row * ldc + col, x);
            }
        EPI_ROWS_END
    }
};
struct EpiSigmoid {
    unsigned char* O;
    __device__ __forceinline__ void operator()(const pg8::f32x4 (&acc)[2][2][4][2], const pg8::Unit& u, int wr, int wc, int fr, int fq) {
        EPI_ROWS_BEGIN
#pragma unroll
            for (int bj = 0; bj < 2; ++bj) {
                const int col = u.pn * 256 + bj * 128 + wc * 32 + fq * 8;
                float x[8] = {acc[ai][bj][m][0][0], acc[ai][bj][m][0][1], acc[ai][bj][m][0][2], acc[ai][bj][m][0][3], acc[ai][bj][m][1][0], acc[ai][bj][m][1][1], acc[ai][bj][m][1][2], acc[ai][bj][m][1][3]};
#pragma unroll
                for (int k = 0; k < 8; ++k) x[k] = fast_rcp(1.f + fast_exp2((-LOG2E * UW8_INV) * x[k]));
                int lo = __builtin_amdgcn_cvt_pk_fp8_f32(x[0], x[1], 0, false); lo = __builtin_amdgcn_cvt_pk_fp8_f32(x[2], x[3], lo, true);
                int hi2 = __builtin_amdgcn_cvt_pk_fp8_f32(x[4], x[5], 0, false); hi2 = __builtin_amdgcn_cvt_pk_fp8_f32(x[6], x[7], hi2, true);
                *(GAS unsigned long long*)(O + (size_t)row * 1024 + col) = (unsigned long long)(unsigned)lo | ((unsigned long long)(unsigned)hi2 << 32);
            }
        EPI_ROWS_END
    }
};
struct EpiGated {
    const unsigned char* G; unsigned char* Pp; unsigned char* Mg8; int n;
    __device__ __forceinline__ void operator()(const pg8::f32x4 (&acc)[2][2][4][2], const pg8::Unit& u, int wr, int wc, int fr, int fq) {
        EPI_ROWS_BEGIN
#pragma unroll
            for (int bj = 0; bj < 2; ++bj) {
                const int col = u.pn * 256 + bj * 128 + wc * 32 + fq * 8; const size_t off = (size_t)row * 1024 + col;
                float x[8] = {acc[ai][bj][m][0][0], acc[ai][bj][m][0][1], acc[ai][bj][m][0][2], acc[ai][bj][m][0][3], acc[ai][bj][m][1][0], acc[ai][bj][m][1][1], acc[ai][bj][m][1][2], acc[ai][bj][m][1][3]};
#pragma unroll
                for (int k = 0; k < 8; ++k) x[k] *= 1.f / (O8_SCALE * W8_SCALE);
                { const unsigned long long g = *(const GAS unsigned long long*)(G + off); const int g0 = (int)(unsigned)g, g1 = (int)(unsigned)(g >> 32);
                  const f32x2 a = __builtin_amdgcn_cvt_pk_f32_fp8(g0, false), b = __builtin_amdgcn_cvt_pk_f32_fp8(g0, true), c = __builtin_amdgcn_cvt_pk_f32_fp8(g1, false), d = __builtin_amdgcn_cvt_pk_f32_fp8(g1, true);
                  x[0] *= a.x; x[1] *= a.y; x[2] *= b.x; x[3] *= b.y; x[4] *= c.x; x[5] *= c.y; x[6] *= d.x; x[7] *= d.y; }
                if (n > 0) { const unsigned long long o = *(const GAS unsigned long long*)(Pp + off); const int o0 = (int)(unsigned)o, o1 = (int)(unsigned)(o >> 32);
                  const f32x2 a = __builtin_amdgcn_cvt_pk_f32_fp8(o0, false), b = __builtin_amdgcn_cvt_pk_f32_fp8(o0, true), c = __builtin_amdgcn_cvt_pk_f32_fp8(o1, false), d = __builtin_amdgcn_cvt_pk_f32_fp8(o1, true);
                  x[0] += a.x * (1.f / 64.f); x[1] += a.y * (1.f / 64.f); x[2] += b.x * (1.f / 64.f); x[3] += b.y * (1.f / 64.f); x[4] += c.x * (1.f / 64.f); x[5] += c.y * (1.f / 64.f); x[6] += d.x * (1.f / 64.f); x[7] += d.y * (1.f / 64.f); }
                { float y[8]; unsigned char* dst_ = (n < 3) ? Pp : Mg8;
#pragma unroll
                    for (int k = 0; k < 8; ++k) y[k] = __builtin_amdgcn_fmed3f(x[k] * 64.f, -440.f, 440.f);
                    int lo = __builtin_amdgcn_cvt_pk_fp8_f32(y[0], y[1], 0, false); lo = __builtin_amdgcn_cvt_pk_fp8_f32(y[2], y[3], lo, true);
                    int hi2 = __builtin_amdgcn_cvt_pk_fp8_f32(y[4], y[5], 0, false); hi2 = __builtin_amdgcn_cvt_pk_fp8_f32(y[6], y[7], hi2, true);
                    *(GAS unsigned long long*)(dst_ + off) = (unsigned long long)(unsigned)lo | ((unsigned long long)(unsigned)hi2 << 32); }
            }
        EPI_ROWS_END
    }
};
struct EpiResid {
    const float* X; float* Z; const float* gate;
    __device__ __forceinline__ void operator()(const pg8::f32x4 (&acc)[2][2][4][2], const pg8::Unit& u, int wr, int wc, int fr, int fq) {
        EPI_ROWS_BEGIN
            const float* gb = gate + (size_t)(row / SEQ) * 6144;
#pragma unroll
            for (int bj = 0; bj < 2; ++bj) {
                const int col = u.pn * 256 + bj * 128 + wc * 32 + fq * 8; const size_t off = (size_t)row * 1024 + col;
#pragma unroll
                for (int n = 0; n < 2; ++n) { const f32x4 xv = *(const GAS f32x4*)(X + off + 4 * n), gv = *(const GAS f32x4*)(gb + col + 4 * n);
                    f32x4 a; a.x = acc[ai][bj][m][n][0]; a.y = acc[ai][bj][m][n][1]; a.z = acc[ai][bj][m][n][2]; a.w = acc[ai][bj][m][n][3];
                    *(GAS f32x4*)(Z + off + 4 * n) = xv * DN_ALPHA + gv * (a * (1.f / (64.f * W8_SCALE))); }
            }
        EPI_ROWS_END
    }
};

__device__ __forceinline__ float max3f(float a, float b, float c) { float r; asm("v_max3_f32 %0, %1, %2, %3" : "=v"(r) : "v"(a), "v"(b), "v"(c)); return r; }
__device__ __forceinline__ float max2f(float a, float b) { float r; asm("v_max_f32_e32 %0, %1, %2" : "=v"(r) : "v"(a), "v"(b)); return r; }
__device__ __forceinline__ float fadd_s(float a, float b) { float r; asm("v_add_f32_e32 %0, %1, %2" : "=v"(r) : "v"(a), "v"(b)); return r; }
__device__ __forceinline__ float fsub_s(float a, float b) { float r; asm("v_sub_f32_e32 %0, %1, %2" : "=v"(r) : "v"(a), "v"(b)); return r; }
__device__ __forceinline__ int crow(int r, int hi) { return (r & 3) + 8 * (r >> 2) + 4 * hi; }
__device__ __forceinline__ s16x4 vtr(const LAS unsigned char* p) { typedef short v4i16_t __attribute__((ext_vector_type(4))); return __builtin_bit_cast(s16x4, __builtin_amdgcn_ds_read_tr16_b64_v4i16((LAS v4i16_t*)p)); }

__device__ __forceinline__ void dma16(const void* g, LAS unsigned char* l) {
    const unsigned dst = (unsigned)__builtin_amdgcn_readfirstlane((int)(unsigned)(size_t)l); unsigned keep;
    asm volatile("s_mov_b32 %0, m0\n\ts_mov_b32 m0, %2\n\ts_nop 0\n\tglobal_load_lds_dwordx4 %1, off\n\ts_mov_b32 m0, %0" : "=&s"(keep) : "v"(g), "s"(dst) : "memory");
}
template <int N> __device__ __forceinline__ void wait_vm() { if constexpr (N == 0) asm volatile("s_waitcnt vmcnt(0)" ::: "memory"); else if constexpr (N == 1) asm volatile("s_waitcnt vmcnt(1)" ::: "memory"); else if constexpr (N == 2) asm volatile("s_waitcnt vmcnt(2)" ::: "memory");
    else if constexpr (N == 3) asm volatile("s_waitcnt vmcnt(3)" ::: "memory"); else if constexpr (N == 4) asm volatile("s_waitcnt vmcnt(4)" ::: "memory"); else asm volatile("s_waitcnt vmcnt(6)" ::: "memory"); }
#define FL_BAR() do { asm volatile("s_waitcnt lgkmcnt(0)" ::: "memory"); __builtin_amdgcn_s_barrier(); asm volatile("" ::: "memory"); } while (0)
typedef int i32x4_t __attribute__((ext_vector_type(4)));
typedef int i32x8_t __attribute__((ext_vector_type(8)));
template <class P, int VAR = 0, bool FIX = false>
__device__ __forceinline__ void flash_run(const P& pol, LAS unsigned char* lds, const bf16x8 (&qf)[P::DQK / 16], f32x16 (&o)[P::DV / 32], float& m_io, float& l_io) {
    constexpr int DQK = P::DQK, DV = P::DV, NDB = DV / 32, PPW = P::PPW, STAGE = P::STAGE, VOFF = P::VOFF;
    constexpr bool LSUM = FIX && P::LSUM;
    constexpr bool NEGM = P::NEGM && !FIX;
    int tid = threadIdx.x; asm volatile("" : "+v"(tid)); const int lane = tid & 63, r32 = lane & 31, hi = lane >> 5; const int wave = __builtin_amdgcn_readfirstlane(tid >> 6);
    const int nt = pol.ntiles;
    const int koff0 = r32 * 128 + 16 * (hi ^ ((r32 >> 1) & 7));
#define FL_DMA(t) pol.dma((t), lds + ((t) & 3) * STAGE, wave, lane)
#define FL_QK(S0, S1, st) do { const LAS unsigned char* kb_ = lds + (st) * STAGE; \
      if constexpr (P::KF8) {        \
        const int ko8_ = r32 * 64 + 16 * ((2 * hi) ^ ((r32 >> 2) & 3)); \
        const i32x4_t q0_ = __builtin_bit_cast(i32x4_t, qf[0]), q1_ = __builtin_bit_cast(i32x4_t, qf[1]); const i32x8_t qq_ = {q0_.x, q0_.y, q0_.z, q0_.w, q1_.x, q1_.y, q1_.z, q1_.w}; \
        const i32x4_t a0_ = *(const LAS i32x4_t*)(kb_ + ko8_), a1_ = *(const LAS i32x4_t*)(kb_ + (ko8_ ^ 16)), b0_ = *(const LAS i32x4_t*)(kb_ + 2048 + ko8_), b1_ = *(const LAS i32x4_t*)(kb_ + 2048 + (ko8_ ^ 16)); \
        const i32x8_t ka8_ = {a0_.x, a0_.y, a0_.z, a0_.w, a1_.x, a1_.y, a1_.z, a1_.w}, kb8_ = {b0_.x, b0_.y, b0_.z, b0_.w, b1_.x, b1_.y, b1_.z, b1_.w}; \
        if constexpr (P::VF8) {        \
        asm volatile("v_mfma_scale_f32_32x32x64_f8f6f4 %0, %1, %2, -2.0, %3, %3 op_sel_hi:[0,0,0]" : "=&v"(S0) : "v"(ka8_), "v"(qq_), "v"(0x7F7F7F7F)); \
        asm volatile("v_mfma_scale_f32_32x32x64_f8f6f4 %0, %1, %2, -2.0, %3, %3 op_sel_hi:[0,0,0]" : "=&v"(S1) : "v"(kb8_), "v"(qq_), "v"(0x7F7F7F7F)); \
        } else { \
        asm volatile("v_mfma_scale_f32_32x32x64_f8f6f4 %0, %1, %2, 0, %3, %3 op_sel_hi:[0,0,0]" : "=&v"(S0) : "v"(ka8_), "v"(qq_), "v"(0x7F7F7F7F)); \
        asm volatile("v_mfma_scale_f32_32x32x64_f8f6f4 %0, %1, %2, 0, %3, %3 op_sel_hi:[0,0,0]" : "=&v"(S1) : "v"(kb8_), "v"(qq_), "v"(0x7F7F7F7F)); } \
        if constexpr (DQK > 64) {        \
            bf16x8 kr_[4]; \
            _Pragma("unroll") for (int s_ = 0; s_ < 2; ++s_) { kr_[s_] = *(const LAS bf16x8*)(kb_ + 8192 + (koff0 ^ (32 * s_))); kr_[2 + s_] = *(const LAS bf16x8*)(kb_ + 8192 + 4096 + (koff0 ^ (32 * s_))); } \
            asm volatile("s_nop 7\n\ts_nop 7\n\ts_nop 7" ::: "memory"); \
            _Pragma("unroll") for (int s_ = 0; s_ < 2; ++s_) S0 = __builtin_amdgcn_mfma_f32_32x32x16_bf16(kr_[s_], qf[4 + s_], S0, 0, 0, 0); \
            _Pragma("unroll") for (int s_ = 0; s_ < 2; ++s_) S1 = __builtin_amdgcn_mfma_f32_32x32x16_bf16(kr_[2 + s_], qf[4 + s_], S1, 0, 0, 0); } \
      } else { \
        bf16x8 ka_[DQK / 16]; \
        _Pragma("unroll") for (int s_ = 0; s_ < DQK / 16; ++s_) { if constexpr (VAR == 7 || VAR == 9) ka_[s_] = qf[s_]; else ka_[s_] = *(const LAS bf16x8*)(kb_ + (s_ < 4 ? 0 : 8192) + (koff0 ^ (32 * (s_ & 3)))); } \
        __builtin_amdgcn_sched_barrier(0); \
        _Pragma("unroll") for (int s_ = 0; s_ < DQK / 16; ++s_) S0 = __builtin_amdgcn_mfma_f32_32x32x16_bf16(ka_[s_], qf[s_], (s_ == 0) ? cinit : S0, 0, 0, 0); \
        __builtin_amdgcn_sched_barrier(0); \
        _Pragma("unroll") for (int s_ = 0; s_ < DQK / 16; ++s_) { if constexpr (VAR == 7 || VAR == 9) ka_[s_] = qf[(s_ + 1) % (DQK / 16)]; else ka_[s_] = *(const LAS bf16x8*)(kb_ + (s_ < 4 ? 0 : 8192) + 4096 + (koff0 ^ (32 * (s_ & 3)))); } \
        __builtin_amdgcn_sched_barrier(0); \
        _Pragma("unroll") for (int s_ = 0; s_ < DQK / 16; ++s_) S1 = __builtin_amdgcn_mfma_f32_32x32x16_bf16(ka_[s_], qf[s_], (s_ == 0) ? cinit : S1, 0, 0, 0); } } while (0)
    if constexpr (VAR != 10) { FL_DMA(0); FL_DMA(1); FL_DMA(2); }
    float ref = 0.f, mrel = m_io, lrun = l_io;
    f32x16 cinit;
#pragma unroll
    for (int r = 0; r < 16; ++r) cinit[r] = 0.f;
    f32x16 sa0, sa1, sb0, sb1;
    constexpr bool MSUM = FIX && P::VF8 && P::MSUM_OK;
    f32x16 msum_; const int sel1_ = (r32 == 0) ? 0x38383838 : 0;
    const i32x8_t selA_ = {sel1_, sel1_, sel1_, sel1_, sel1_, sel1_, sel1_, sel1_};
#pragma unroll
    for (int r = 0; r < 16; ++r) msum_[r] = 0.f;
    f32x16 ol; const bf16x8 ones8 = {16256, 16256, 16256, 16256, 16256, 16256, 16256, 16256};
#pragma unroll
    for (int r = 0; r < 16; ++r) ol[r] = 0.f;
#pragma unroll
    for (int r = 0; r < 16; ++r) { sa0[r] = 0.f; sa1[r] = 0.f; sb0[r] = 0.f; sb1[r] = 0.f; }
    bool act_cur = pol.active(0), act_next = false;
    if (P::HL && wave >= 4) wait_vm<2 * (PPW - 1)>(); else wait_vm<2 * PPW>();
    FL_BAR();
    if (act_cur && VAR != 2 && VAR != 5 && VAR != 10) { FL_QK(sa0, sa1, 0); pol.mask(0, sa0, sa1); }
#define FL_STEP(C0, C1, N0, N1, t) do { const int t_ = (t); \
        if (t_ + 2 < nt) { if (P::HL && wave >= 4) wait_vm<PPW - 1>(); else wait_vm<PPW>(); } else wait_vm<0>(); \
        if constexpr (VAR != 4) FL_BAR();                \
        if (t_ + 3 < nt && VAR != 10) FL_DMA(t_ + 3); \
        act_next = (t_ + 1 < nt) && pol.active(t_ + 1); \
        __builtin_amdgcn_sched_barrier(0); \
        if (act_next && VAR != 2 && VAR != 5 && VAR != 10) { FL_QK(N0, N1, (t_ + 1) & 3); } \
        __builtin_amdgcn_sched_barrier(0); \
        if (act_cur && VAR != 5 && VAR != 10) { \
          if constexpr (!FIX) { \
            float mx = max3f(C0[0], C0[1], C1[0]), mx2 = max3f(C0[2], C0[3], C1[1]); \
            _Pragma("unroll") for (int r = 4; r < 16; r += 2) { mx = max3f(mx, C0[r], C0[r + 1]); } \
            _Pragma("unroll") for (int r = 2; r < 16; r += 2) { mx2 = max3f(mx2, C1[r], C1[r + 1]); } \
            mx = halves_max(max2f(mx, mx2)); \
            const bool changed = mx > mrel; \
            if (__any(changed)) { \
                const float alpha = changed ? fast_exp2(mrel - mx) : 1.f; \
                lrun *= alpha; \
                _Pragma("unroll") for (int db = 0; db < NDB; ++db) _Pragma("unroll") for (int r = 0; r < 16; ++r) o[db][r] *= alpha; \
                if constexpr (NEGM) { const float delta = changed ? mx : 0.f; \
                    _Pragma("unroll") for (int r = 0; r < 16; ++r) { C0[r] -= delta; C1[r] -= delta; } \
                    if (act_next) { _Pragma("unroll") for (int r = 0; r < 16; ++r) { N0[r] -= delta; N1[r] -= delta; } } \
                    ref += delta; mrel = changed ? 0.f : mrel; \
                    _Pragma("unroll") for (int r = 0; r < 16; ++r) cinit[r] = -ref; \
                } else { mrel = changed ? mx : mrel; } \
            } \
          } \
          if constexpr (P::VF8) {        \
            const LAS unsigned char* vb8_ = lds + (t_ & 3) * STAGE + VOFF + r32 * 64 + 16 * ((2 * hi) ^ ((r32 >> 2) & 3)); \
            float rs = 0.f, rs2 = 0.f; \
            if constexpr (FIX) { _Pragma("unroll") for (int r = 0; r < 16; ++r) { C0[r] = fast_exp2(C0[r]); C1[r] = fast_exp2(C1[r]); } } \
            else { _Pragma("unroll") for (int r = 0; r < 16; ++r) { C0[r] = fast_exp2(C0[r] - mrel); C1[r] = fast_exp2(C1[r] - mrel); } } \
            if constexpr (!MSUM) { float ra_ = C0[0];        \
              _Pragma("unroll") for (int r = 1; r < 16; ++r) ra_ += C0[r]; \
              _Pragma("unroll") for (int r = 0; r < 16; ++r) ra_ += C1[r]; \
              rs = ra_; lrun += rs; } \
            (void)rs; (void)rs2; \
            int pw_[8];        \
            _Pragma("unroll") for (int j = 0; j < 4; ++j) { \
                int u0_, u1_; asm volatile("" : "=v"(u0_), "=v"(u1_));        \
                int w0_ = __builtin_amdgcn_cvt_pk_bf8_f32(C0[4 * j], C0[4 * j + 1], u0_, false); w0_ = __builtin_amdgcn_cvt_pk_bf8_f32(C0[4 * j + 2], C0[4 * j + 3], w0_, true); \
                int w1_ = __builtin_amdgcn_cvt_pk_bf8_f32(C1[4 * j], C1[4 * j + 1], u1_, false); w1_ = __builtin_amdgcn_cvt_pk_bf8_f32(C1[4 * j + 2], C1[4 * j + 3], w1_, true); \
                pw_[j] = w0_; pw_[4 + j] = w1_; } \
            const i32x8_t pp_ = {pw_[0], pw_[1], pw_[2], pw_[3], pw_[4], pw_[5], pw_[6], pw_[7]}; \
            if constexpr (MSUM) asm volatile("s_nop 1\n\tv_mfma_scale_f32_32x32x64_f8f6f4 %0, %1, %2, %0, %3, %3 op_sel_hi:[0,0,0] blgp:1" : "+v"(msum_) : "v"(selA_), "v"(pp_), "v"(0x7F7F7F7F)); \
            _Pragma("unroll") for (int db = 0; db < NDB; ++db) { \
                const i32x4_t v0_ = *(const LAS i32x4_t*)(vb8_ + db * 2048), v1_ = *(const LAS i32x4_t*)((const LAS unsigned char*)((unsigned)(size_t)vb8_ ^ 16u) + db * 2048); \
                const i32x8_t va_ = {v0_.x, v0_.y, v0_.z, v0_.w, v1_.x, v1_.y, v1_.z, v1_.w}; \
                asm volatile("s_nop 1\n\tv_mfma_scale_f32_32x32x64_f8f6f4 %0, %1, %2, %0, %3, %3 op_sel_hi:[0,0,0] blgp:1" : "+v"(o[db]) : "v"(va_), "v"(pp_), "v"(0x7F7F7F7F)); } \
          } else { \
            const LAS unsigned char* vb = lds + (t_ & 3) * STAGE + VOFF + (4 * hi + ((lane & 15) >> 2)) * 64 + ((lane >> 4) & 1) * 32 + (lane & 3) * 8; \
              \
            float rs = 0.f, rs2 = 0.f; \
            bf16x8 pf[4]; \
            if constexpr (VAR == 1) { _Pragma("unroll") for (int r = 0; r < 16; ++r) { C0[r] = C0[r] * 0.001f; } } \
            else if constexpr (NEGM || FIX) { _Pragma("unroll") for (int r = 0; r < 16; ++r) { C0[r] = fast_exp2(C0[r]); } } \
            else { _Pragma("unroll") for (int r = 0; r < 16; ++r) { C0[r] = fast_exp2(C0[r] - mrel); } } \
            if constexpr (!LSUM) { _Pragma("unroll") for (int r = 0; r < 16; ++r) { rs += C0[r]; } } \
            _Pragma("unroll") for (int ks = 0; ks < 2; ++ks) { v4u w; \
                w.x = cvtpk(C0[8 * ks + 0], C0[8 * ks + 1]); w.y = cvtpk(C0[8 * ks + 2], C0[8 * ks + 3]); w.z = cvtpk(C0[8 * ks + 4], C0[8 * ks + 5]); w.w = cvtpk(C0[8 * ks + 6], C0[8 * ks + 7]); pf[ks] = __builtin_bit_cast(bf16x8, w); } \
            __builtin_amdgcn_sched_barrier(0); \
            if constexpr (VAR != 3) _Pragma("unroll") for (int db = 0; db < NDB; ++db) { \
                s16x4 vlo_[2], vhi_[2]; \
                _Pragma("unroll") for (int ks = 0; ks < 2; ++ks) { if constexpr (VAR == 8 || VAR == 9) { const bf16x8 f_ = pf[(ks + db) & 1]; vlo_[ks] = (s16x4){f_[0], f_[1], f_[2], f_[3]}; vhi_[ks] = (s16x4){f_[4], f_[5], f_[6], f_[7]}; } \
                    else { vlo_[ks] = vtr(vb + ((2 * ks) * NDB + db) * 512); vhi_[ks] = vtr(vb + ((2 * ks + 1) * NDB + db) * 512); } } \
                __builtin_amdgcn_sched_barrier(0); \
                _Pragma("unroll") for (int ks = 0; ks < 2; ++ks) { \
                    const bf16x8 vf = {vlo_[ks][0], vlo_[ks][1], vlo_[ks][2], vlo_[ks][3], vhi_[ks][0], vhi_[ks][1], vhi_[ks][2], vhi_[ks][3]}; \
                    o[db] = __builtin_amdgcn_mfma_f32_32x32x16_bf16(vf, pf[ks], o[db], 0, 0, 0); } \
                __builtin_amdgcn_sched_barrier(0); } \
            if constexpr (LSUM) { ol = __builtin_amdgcn_mfma_f32_32x32x16_bf16(ones8, pf[0], ol, 0, 0, 0); ol = __builtin_amdgcn_mfma_f32_32x32x16_bf16(ones8, pf[1], ol, 0, 0, 0); __builtin_amdgcn_sched_barrier(0); } \
              \
            if constexpr (VAR == 1) { _Pragma("unroll") for (int r = 0; r < 16; ++r) { C1[r] = C1[r] * 0.001f; } } \
            else if constexpr (NEGM || FIX) { _Pragma("unroll") for (int r = 0; r < 16; ++r) { C1[r] = fast_exp2(C1[r]); } } \
            else { _Pragma("unroll") for (int r = 0; r < 16; ++r) { C1[r] = fast_exp2(C1[r] - mrel); } } \
            if constexpr (!LSUM) { _Pragma("unroll") for (int r = 0; r < 16; ++r) { rs2 += C1[r]; } } \
            lrun += rs + rs2; \
            _Pragma("unroll") for (int ks = 0; ks < 2; ++ks) { v4u w; \
                w.x = cvtpk(C1[8 * ks + 0], C1[8 * ks + 1]); w.y = cvtpk(C1[8 * ks + 2], C1[8 * ks + 3]); w.z = cvtpk(C1[8 * ks + 4], C1[8 * ks + 5]); w.w = cvtpk(C1[8 * ks + 6], C1[8 * ks + 7]); pf[2 + ks] = __builtin_bit_cast(bf16x8, w); } \
            __builtin_amdgcn_sched_barrier(0); \
            if constexpr (VAR != 3) _Pragma("unroll") for (int db = 0; db < NDB; ++db) { \
                s16x4 vlo_[2], vhi_[2]; \
                _Pragma("unroll") for (int ks = 0; ks < 2; ++ks) { if constexpr (VAR == 8 || VAR == 9) { const bf16x8 f_ = pf[2 + ((ks + db) & 1)]; vlo_[ks] = (s16x4){f_[0], f_[1], f_[2], f_[3]}; vhi_[ks] = (s16x4){f_[4], f_[5], f_[6], f_[7]}; } \
                    else { vlo_[ks] = vtr(vb + ((2 * (ks + 2)) * NDB + db) * 512); vhi_[ks] = vtr(vb + ((2 * (ks + 2) + 1) * NDB + db) * 512); } } \
                __builtin_amdgcn_sched_barrier(0); \
                _Pragma("unroll") for (int ks = 0; ks < 2; ++ks) { \
                    const bf16x8 vf = {vlo_[ks][0], vlo_[ks][1], vlo_[ks][2], vlo_[ks][3], vhi_[ks][0], vhi_[ks][1], vhi_[ks][2], vhi_[ks][3]}; \
                    o[db] = __builtin_amdgcn_mfma_f32_32x32x16_bf16(vf, pf[2 + ks], o[db], 0, 0, 0); } \
                __builtin_amdgcn_sched_barrier(0); } \
            if constexpr (LSUM) { ol = __builtin_amdgcn_mfma_f32_32x32x16_bf16(ones8, pf[2], ol, 0, 0, 0); ol = __builtin_amdgcn_mfma_f32_32x32x16_bf16(ones8, pf[3], ol, 0, 0, 0); __builtin_amdgcn_sched_barrier(0); } \
          } \
        } \
        __builtin_amdgcn_sched_barrier(0); \
        if (act_next) pol.mask(t_ + 1, N0, N1); \
        act_cur = act_next; } while (0)
    int t = 0;
    for (; t + 1 < nt; t += 2) { FL_STEP(sa0, sa1, sb0, sb1, t); FL_STEP(sb0, sb1, sa0, sa1, t + 1); }
    if (t < nt) FL_STEP(sa0, sa1, sb0, sb1, t);
    FL_BAR();
    if constexpr (P::VF8) asm volatile("s_nop 7\n\ts_nop 7\n\ts_nop 7" ::: "memory");
    if constexpr (MSUM) lrun = (hi == 0) ? msum_[0] : 0.f;
    m_io = NEGM ? ref + mrel : mrel; l_io = LSUM ? lrun + 0.5f * ol[0] : lrun;
#undef FL_STEP
#undef FL_DMA
#undef FL_QK
}

template <int NDB>
__device__ __forceinline__ void store_o(const f32x16 (&o)[NDB], float scale, bf16* orow, int hi) {
#pragma unroll
    for (int db = 0; db < NDB; ++db)
#pragma unroll
        for (int g = 0; g < 4; ++g) {
            const unsigned lo = cvtpk(o[db][4 * g] * scale, o[db][4 * g + 1] * scale), hh = cvtpk(o[db][4 * g + 2] * scale, o[db][4 * g + 3] * scale);
            *(GAS unsigned long long*)(orow + 32 * db + 8 * g + 4 * hi) = (unsigned long long)lo | ((unsigned long long)hh << 32); }
}

template <int NDB>
__device__ __forceinline__ void store_o8(const f32x16 (&o)[NDB], float scale, unsigned char* orow, int hi) {
    const float sc = scale * O8_SCALE;
#pragma unroll
    for (int db = 0; db < NDB; ++db)
#pragma unroll
        for (int g = 0; g < 4; ++g) {
            const float y0 = __builtin_amdgcn_fmed3f(o[db][4 * g] * sc, -440.f, 440.f), y1 = __builtin_amdgcn_fmed3f(o[db][4 * g + 1] * sc, -440.f, 440.f), y2 = __builtin_amdgcn_fmed3f(o[db][4 * g + 2] * sc, -440.f, 440.f), y3 = __builtin_amdgcn_fmed3f(o[db][4 * g + 3] * sc, -440.f, 440.f);
            int wd = __builtin_amdgcn_cvt_pk_fp8_f32(y0, y1, 0, false); wd = __builtin_amdgcn_cvt_pk_fp8_f32(y2, y3, wd, true);
            *(GAS int*)(orow + 32 * db + 8 * g + 4 * hi) = wd; }
}

#ifndef FORCE_SAFE_SOFTMAX
#define FORCE_SAFE_SOFTMAX 0
#endif
struct PolMLA {
    static constexpr bool KF8 = true, VF8 = true, HL = false, MSUM_OK = true; static constexpr bool LSUM = false; static constexpr int DQK = 96, DV = 64, PPW = 2, STAGE = 24576, VOFF = 16384; static constexpr bool NEGM = false;
    const unsigned char* g0; const bf16* g1; int ntiles;
    static __device__ __forceinline__ int keyof(int row) { const int mrow = row & 31, cc = 32 * ((mrow >> 2) & 1) + 16 * (row >> 5) + (mrow & 3) + 4 * (mrow >> 3); return 16 * (cc & 3) + (cc >> 2); }
    __device__ __forceinline__ void init(const unsigned char* kn8  , const bf16* kr, const unsigned char* vt, int w, int lane) {
        const int row = 8 * w + (lane >> 3), c = (lane & 7) ^ ((row >> 1) & 7);
        const int r8 = 16 * (w & 3) + (lane >> 2), c8 = (lane & 3) ^ ((r8 >> 2) & 3);
        g0 = (w < 4) ? kn8 + (size_t)keyof(r8) * 2048 + 16 * c8 : vt + (size_t)r8 * SEQ + 16 * c8;
        g1 = kr + (size_t)keyof(row) * 768 + 8 * c; }
    __device__ __forceinline__ void dma(int t, LAS unsigned char* st, int w, int lane) const {
        if (w < 4) dma16(g0 + (size_t)t * (64 * 2048), st + w * 1024); else dma16(g0 + t * 64, st + 16384 + (w - 4) * 1024);
        dma16(g1 + (size_t)t * (64 * 768), st + 8192 + w * 1024);
    }
    __device__ __forceinline__ bool active(int) const { return true; }
    __device__ __forceinline__ void mask(int, f32x16&, f32x16&) const {}
};
template <int VAR = 0>
__device__ __forceinline__ void mla_unit(unsigned char* ws, LAS unsigned char* lds, int b, int h, int qb, int wave_, int lane_) {
    int tidl_ = threadIdx.x; asm volatile("" : "+v"(tidl_)); const int lane = tidl_ & 63, wave = __builtin_amdgcn_readfirstlane(tidl_ >> 6); (void)lane_;
    const int r32 = lane & 31, hi = lane >> 5; const size_t row = (size_t)b * SEQ + qb * 256 + wave * 32 + r32;
    bf16* qn = (bf16*)(ws + WS_MQN) + row * 512 + h * 64; const bf16* qr = (const bf16*)(ws + WS_MQR) + row * 256 + h * 32;
    bf16x8 qf[6];
    { const bf16* qs = qn + 32 * hi; int w8[8];
#pragma unroll
      for (int s = 0; s < 4; ++s) { const v4u raw = *(const GAS v4u*)(qs + 8 * s);
          int lo = __builtin_amdgcn_cvt_pk_fp8_f32(bf_lo(raw.x), bf_hi(raw.x), 0, false); lo = __builtin_amdgcn_cvt_pk_fp8_f32(bf_lo(raw.y), bf_hi(raw.y), lo, true);
          int hi2 = __builtin_amdgcn_cvt_pk_fp8_f32(bf_lo(raw.z), bf_hi(raw.z), 0, false); hi2 = __builtin_amdgcn_cvt_pk_fp8_f32(bf_lo(raw.w), bf_hi(raw.w), hi2, true);
          w8[2 * s] = lo; w8[2 * s + 1] = hi2; }
      const i32x4_t f0 = {w8[0], w8[1], w8[2], w8[3]}, f1 = {w8[4], w8[5], w8[6], w8[7]};
      qf[0] = __builtin_bit_cast(bf16x8, f0); qf[1] = __builtin_bit_cast(bf16x8, f1); qf[2] = qf[0]; qf[3] = qf[1]; }
#pragma unroll
    for (int s = 0; s < 2; ++s) {
        const v4u raw = *(const GAS v4u*)(qr + 16 * s + 8 * hi);
        float x[8] = {bf_lo(raw.x), bf_hi(raw.x), bf_lo(raw.y), bf_hi(raw.y), bf_lo(raw.z), bf_hi(raw.z), bf_lo(raw.w), bf_hi(raw.w)};
        rope4(x, (const f32x2*)(ws + WS_ROPE32) + (size_t)(qb * 256 + wave * 32 + r32) * 16 + 8 * s + 4 * hi);
        v4u w; w.x = cvtpk(x[0], x[1]); w.y = cvtpk(x[2], x[3]); w.z = cvtpk(x[4], x[5]); w.w = cvtpk(x[6], x[7]);
        qf[4 + s] = __builtin_bit_cast(bf16x8, w); }
    PolMLA pol; pol.init(ws + WS_KVB + (size_t)b * SEQ * 2048 + h * 64, (const bf16*)(ws + WS_LAT) + (size_t)b * SEQ * 768 + 640,
                         ws + WS_DIFV + 16 * MiB + (size_t)(b * 8 + h) * 64 * SEQ, wave, lane); pol.ntiles = SEQ / 64;
    f32x16 o[2];
#pragma unroll
    for (int r = 0; r < 16; ++r) { o[0][r] = 0.f; o[1][r] = 0.f; }
    float m = -1e30f, l = 0.f;
    flash_run<PolMLA, VAR, true>(pol, lds, qf, o, m, l);
    l = halves_sum(l);
    if (__any(!(l > 1e-30f && l < 1e25f) || FORCE_SAFE_SOFTMAX)) {
#pragma unroll
        for (int r = 0; r < 16; ++r) { o[0][r] = 0.f; o[1][r] = 0.f; }
        m = -1e30f; l = 0.f;
        flash_run<PolMLA, VAR, false>(pol, lds, qf, o, m, l);
        l = halves_sum(l);
    }
    { int tid2_ = threadIdx.x; asm volatile("" : "+v"(tid2_)); const int lane2 = tid2_ & 63, wave2 = __builtin_amdgcn_readfirstlane(tid2_ >> 6);
      unsigned char* o8 = ws + WS_U + (size_t)wave_ * 32 * MiB + 16 * MiB + ((size_t)b * SEQ + qb * 256 + wave2 * 32 + (lane2 & 31)) * 512 + h * 64;
      store_o8<2>(o, fast_rcp(l), o8, lane2 >> 5); }
}

struct PolDiff {
    static constexpr bool KF8 = true, VF8 = true, HL = true, MSUM_OK = true; static constexpr bool LSUM = false; static constexpr int DQK = 64, DV = 128, PPW = 2, STAGE = 24576, VOFF = 8192; static constexpr bool NEGM = false;
    const unsigned char* g0; const unsigned char* g1; int ntiles;
    __device__ __forceinline__ void init(const unsigned char* k8, const unsigned char* vt, int w, int lane) {
        const int row = 16 * (w & 3) + (lane >> 2), c = (lane & 3) ^ ((row >> 2) & 3);
        const int mrow = row & 31, cc = 32 * ((mrow >> 2) & 1) + 16 * (row >> 5) + (mrow & 3) + 4 * (mrow >> 3), key = 16 * (cc & 3) + (cc >> 2);
        g0 = k8 + (size_t)key * 512 + 16 * c;
        const int drow = 16 * w + (lane >> 2), vc = (lane & 3) ^ ((drow >> 2) & 3); g1 = vt + (size_t)drow * SEQ + 16 * vc; }
    __device__ __forceinline__ void dma(int t, LAS unsigned char* st, int w, int lane) const {
        if (w < 4) dma16(g0 + (size_t)t * (64 * 512), st + w * 1024);
        dma16(g1 + t * 64, st + 8192 + w * 1024);
    }
    __device__ __forceinline__ bool active(int) const { return true; }
    __device__ __forceinline__ void mask(int, f32x16&, f32x16&) const {}
};
template <int VAR = 0>
__device__ __forceinline__ void diff_unit(unsigned char* ws, LAS unsigned char* lds, int b, int h, int qb, int wave_, int lane_, const float* lq1, const float* lk1, const float* lq2, const float* lk2, float lam_init, const float* subln) {
    (void)wave_; (void)lane_;
#define DIFF_IDS int tidl_ = threadIdx.x; asm volatile("" : "+v"(tidl_)); const int lane = tidl_ & 63, wave = __builtin_amdgcn_readfirstlane(tidl_ >> 6); const int r32 = lane & 31, hi = lane >> 5; \
        const size_t row = (size_t)b * SEQ + qb * 256 + wave * 32 + r32; bf16* q = (bf16*)(ws + WS_DIFQ) + row * 512 + h * 128; \
        bf16* scr = (bf16*)(ws + WS_DSCR) + ((size_t)blockIdx.x * 256 + wave * 32 + r32) * 128; (void)q; (void)scr; (void)hi;
    for (int mp = 0; mp < 2; ++mp) {
        bf16x8 qf[4]; PolDiff pol;
        { DIFF_IDS
          { const bf16* qs = q + 64 * mp + 32 * hi; int w8[8];
#pragma unroll
            for (int s = 0; s < 4; ++s) { const v4u raw = *(const GAS v4u*)(qs + 8 * s);
                int lo = __builtin_amdgcn_cvt_pk_fp8_f32(bf_lo(raw.x), bf_hi(raw.x), 0, false); lo = __builtin_amdgcn_cvt_pk_fp8_f32(bf_lo(raw.y), bf_hi(raw.y), lo, true);
                int hi2 = __builtin_amdgcn_cvt_pk_fp8_f32(bf_lo(raw.z), bf_hi(raw.z), 0, false); hi2 = __builtin_amdgcn_cvt_pk_fp8_f32(bf_lo(raw.w), bf_hi(raw.w), hi2, true);
                w8[2 * s] = lo; w8[2 * s + 1] = hi2; }
            const i32x4_t f0 = {w8[0], w8[1], w8[2], w8[3]}, f1 = {w8[4], w8[5], w8[6], w8[7]};
            qf[0] = __builtin_bit_cast(bf16x8, f0); qf[1] = __builtin_bit_cast(bf16x8, f1); qf[2] = qf[0]; qf[3] = qf[1]; }
          pol.init(ws + WS_DIFK + (size_t)b * SEQ * 512 + h * 128 + 64 * mp, ws + WS_DIFV + (size_t)(b * 4 + h) * 128 * SEQ, wave, lane); pol.ntiles = SEQ / 64; }
        f32x16 o[4];
#pragma unroll
        for (int d = 0; d < 4; ++d)
#pragma unroll
            for (int r = 0; r < 16; ++r) o[d][r] = 0.f;
        float m = -1e30f, l = 0.f;
        flash_run<PolDiff, VAR, true>(pol, lds, qf, o, m, l);
        l = halves_sum(l);
        if (__any(!(l > 1e-30f && l < 1e25f) || FORCE_SAFE_SOFTMAX)) {
#pragma unroll
            for (int d = 0; d < 4; ++d)
#pragma unroll
                for (int r = 0; r < 16; ++r) o[d][r] = 0.f;
            m = -1e30f; l = 0.f;
            flash_run<PolDiff, VAR, false>(pol, lds, qf, o, m, l);
            l = halves_sum(l);
        }
        const float il = fast_rcp(l);
        DIFF_IDS
        if (mp == 0) {
            store_o<4>(o, il, scr, hi);
            asm volatile("s_waitcnt vmcnt(0)" ::: "memory");
        } else {
            const float lam = expf(wave_sum(lq1[lane] * lk1[lane])) - expf(wave_sum(lq2[lane] * lk2[lane])) + lam_init; const float post = 1.f - lam_init;
            const float il2 = lam * il; float ss = 0.f;
#pragma unroll
            for (int d = 0; d < 4; ++d)
#pragma unroll
                for (int g = 0; g < 4; ++g) { const unsigned long long w = *(const GAS unsigned long long*)(scr + 32 * d + 8 * g + 4 * hi); const unsigned w0 = (unsigned)w, w1 = (unsigned)(w >> 32);
                    o[d][4 * g] = bf_lo(w0) - il2 * o[d][4 * g]; o[d][4 * g + 1] = bf_hi(w0) - il2 * o[d][4 * g + 1]; o[d][4 * g + 2] = bf_lo(w1) - il2 * o[d][4 * g + 2]; o[d][4 * g + 3] = bf_hi(w1) - il2 * o[d][4 * g + 3];
                    ss += o[d][4 * g] * o[d][4 * g] + o[d][4 * g + 1] * o[d][4 * g + 1] + o[d][4 * g + 2] * o[d][4 * g + 2] + o[d][4 * g + 3] * o[d][4 * g + 3]; }
            ss = halves_sum(ss);
            const float rn = post / sqrtf(ss * (1.f / 128.f) + LN_EPS);
#pragma unroll
            for (int d = 0; d < 4; ++d)
#pragma unroll
                for (int g = 0; g < 4; ++g) { const f32x4 gv = *(const GAS f32x4*)(subln + 32 * d + 8 * g + 4 * hi);
                    o[d][4 * g] *= gv.x; o[d][4 * g + 1] *= gv.y; o[d][4 * g + 2] *= gv.z; o[d][4 * g + 3] *= gv.w; }
            store_o8<4>(o, rn, ws + WS_LAT + row * 1536 + h * 128, hi);
        }
    }
#undef DIFF_IDS
}

struct PolSWA {
    static constexpr bool KF8 = false, VF8 = false, HL = false, MSUM_OK = false; static constexpr bool LSUM = false; static constexpr int DQK = 64, DV = 64, PPW = 2, STAGE = 16384, VOFF = 8192; static constexpr bool NEGM = true;
    const bf16 *k, *v; int ntiles; int kv0; int qw; int q;
    int hi;
    __device__ __forceinline__ int kvrow(int t, int row) const { int kv = kv0 + t * 64 + row; kv = kv < 0 ? 0 : kv; return kv > SEQ - 1 ? SEQ - 1 : kv; }
    __device__ __forceinline__ void dma(int t, LAS unsigned char* st, int w, int lane) const {
        const int row = 8 * w + (lane >> 3), c = (lane & 7) ^ ((row >> 1) & 7);
        dma16(k + (size_t)kvrow(t, row) * 256 + 8 * c, st + w * 1024);
        const int sub = 2 * w + (lane >> 5), vrow = 8 * (sub >> 1) + ((lane >> 2) & 7), vc = 32 * (sub & 1) + 8 * (lane & 3);
        dma16(v + (size_t)kvrow(t, vrow) * 256 + vc, st + 8192 + w * 1024);
    }
    __device__ __forceinline__ bool active(int t) const { const int lo = kv0 + t * 64; return (lo + 63 >= qw - 128) && (lo <= qw + 31 + 128) && (lo + 63 >= 0) && (lo < SEQ); }
    __device__ __forceinline__ void mask(int t, f32x16& p0, f32x16& p1) const {
        const int lo = kv0 + t * 64;
#pragma unroll
        for (int r = 0; r < 16; ++r) { const int kv = lo + crow(r, hi); const int d0 = q - kv, d1 = d0 - 32;
            if (d0 > 128 || d0 < -128 || kv < 0 || kv >= SEQ) p0[r] = -INFINITY;
            if (d1 > 128 || d1 < -128 || kv + 32 < 0 || kv + 32 >= SEQ) p1[r] = -INFINITY; }
    }
};
__device__ __forceinline__ void swa_unit(unsigned char* ws, LAS unsigned char* lds, int b, int h, int qb, int wave_, int lane_, float sink2) {
    int tidl_ = threadIdx.x; asm volatile("" : "+v"(tidl_)); const int lane = tidl_ & 63, wave = __builtin_amdgcn_readfirstlane(tidl_ >> 6); (void)wave_; (void)lane_;
    const int r32 = lane & 31, hi = lane >> 5; const int qw = qb * 256 + wave * 32; const size_t row = (size_t)b * SEQ + qw + r32;
    bf16* q = (bf16*)(ws + WS_SWAQ) + row * 512 + h * 64;
    bf16x8 qf[4];
#pragma unroll
    for (int s = 0; s < 4; ++s) qf[s] = *(const GAS bf16x8*)(q + 16 * s + 8 * hi);
    PolSWA pol; pol.k = (const bf16*)(ws + WS_SWAKV) + (size_t)b * SEQ * 256 + (h >> 2) * 64; pol.v = pol.k + 128;
    pol.ntiles = 8; pol.kv0 = qb * 256 - 128; pol.qw = qw; pol.q = qw + r32; pol.hi = hi;
    f32x16 o[2];
#pragma unroll
    for (int r = 0; r < 16; ++r) { o[0][r] = 0.f; o[1][r] = 0.f; }
    float m = -1e30f, l = 0.f;
    flash_run<PolSWA, 0, true>(pol, lds, qf, o, m, l);
    l = halves_sum(l) + fast_exp2(sink2);
    if (__any(!(l > 1e-30f && l < 1e25f) || FORCE_SAFE_SOFTMAX)) {
#pragma unroll
        for (int r = 0; r < 16; ++r) { o[0][r] = 0.f; o[1][r] = 0.f; }
        m = -1e30f; l = 0.f;
        flash_run<PolSWA, 0, false>(pol, lds, qf, o, m, l);
        l = halves_sum(l) + fast_exp2(sink2 - m);
    }
    store_o8<2>(o, fast_rcp(l), ws + WS_U + (size_t)wave_ * 32 * MiB + row * 512 + h * 64, hi);
}

struct PolNAT {
    static constexpr bool KF8 = false, VF8 = false, HL = false, MSUM_OK = false; static constexpr bool LSUM = false; static constexpr int DQK = 64, DV = 64, PPW = 2, STAGE = 16384, VOFF = 8192; static constexpr bool NEGM = true;
    const bf16 *k, *v; int ntiles; int tr0; int r; int j; int hi; const LAS float* bias;
    __device__ __forceinline__ void dma(int t, LAS unsigned char* st, int w, int lane) const {
        const int row = 8 * w + (lane >> 3), c = (lane & 7) ^ ((row >> 1) & 7);
        dma16(k + ((size_t)(tr0 + t) * 64 + row) * 512 + 8 * c, st + w * 1024);
        const int sub = 2 * w + (lane >> 5), vrow = 8 * (sub >> 1) + ((lane >> 2) & 7), vc = 32 * (sub & 1) + 8 * (lane & 3);
        dma16(v + ((size_t)(tr0 + t) * 64 + vrow) * 512 + vc, st + 8192 + w * 1024);
    }
    __device__ __forceinline__ int r0() const { int x = r - 4; x = x < 0 ? 0 : x; return x > 120 ? 120 : x; }
    __device__ __forceinline__ bool active(int t) const { const int kr = tr0 + t, a = r0(); return kr >= a && kr < a + 8; }
    __device__ __forceinline__ void mask(int t, f32x16& p0, f32x16& p1) const {
        int c0 = j - 8; c0 = c0 < 0 ? 0 : c0; c0 = c0 > 48 ? 48 : c0;
        const LAS float* brow = bias + ((tr0 + t) - r + 7) * 31 + (15 - j);
#pragma unroll
        for (int rr = 0; rr < 16; ++rr) { const int kc = crow(rr, hi);
            p0[rr] = (kc >= c0 && kc < c0 + 16) ? p0[rr] + brow[kc] : -INFINITY;
            p1[rr] = (kc + 32 >= c0 && kc + 32 < c0 + 16) ? p1[rr] + brow[kc + 32] : -INFINITY; }
    }
};
__device__ __forceinline__ void nat_unit(unsigned char* ws, LAS unsigned char* lds, const LAS float* bias_all, int b, int h, int rg, int wave_, int lane_) {
    int tidl_ = threadIdx.x; asm volatile("" : "+v"(tidl_)); const int lane = tidl_ & 63, wave = __builtin_amdgcn_readfirstlane(tidl_ >> 6); (void)wave_; (void)lane_;
    const int r32 = lane & 31, hi = lane >> 5; const int r = 4 * rg + (wave >> 1), j = 32 * (wave & 1) + r32; const size_t row = (size_t)b * SEQ + r * 64 + j;
    bf16* q = (bf16*)(ws + WS_NATQ) + row * 512 + h * 64;
    bf16x8 qf[4];
#pragma unroll
    for (int s = 0; s < 4; ++s) qf[s] = *(const GAS bf16x8*)(q + 16 * s + 8 * hi);
    int ra = 4 * rg - 4; ra = ra < 0 ? 0 : ra; ra = ra > 120 ? 120 : ra; int rb = 4 * rg - 1; rb = rb < 0 ? 0 : rb; rb = rb > 120 ? 120 : rb;
    PolNAT pol; pol.k = (const bf16*)(ws + WS_NATK) + (size_t)b * SEQ * 512 + h * 64; pol.v = (const bf16*)(ws + WS_NATV) + (size_t)b * SEQ * 512 + h * 64;
    pol.tr0 = ra; pol.ntiles = rb + 7 - ra + 1; pol.r = r; pol.j = j; pol.hi = hi; pol.bias = bias_all + h * 465;
    f32x16 o[2];
#pragma unroll
    for (int rr = 0; rr < 16; ++rr) { o[0][rr] = 0.f; o[1][rr] = 0.f; }
    float m = -1e30f, l = 0.f;
    flash_run<PolNAT, 0, true>(pol, lds, qf, o, m, l);
    l = halves_sum(l);
    if (__any(!(l > 1e-30f && l < 1e25f) || FORCE_SAFE_SOFTMAX)) {
#pragma unroll
        for (int rr = 0; rr < 16; ++rr) { o[0][rr] = 0.f; o[1][rr] = 0.f; }
        m = -1e30f; l = 0.f;
        flash_run<PolNAT, 0, false>(pol, lds, qf, o, m, l);
        l = halves_sum(l);
    }
    store_o8<2>(o, fast_rcp(l), ws + WS_LAT + row * 1536 + 512 + h * 64, hi);
}


__device__ __forceinline__ unsigned f2key(float f) { const unsigned u = __float_as_uint(f); return (u & 0x80000000u) ? ~u : (u | 0x80000000u); }
__device__ __forceinline__ float key2f(unsigned k) { const unsigned u = (k & 0x80000000u) ? (k & 0x7fffffffu) : ~k; return __uint_as_float(u); }
__device__ __forceinline__ unsigned umax2(unsigned a, unsigned b) { return a > b ? a : b; }
__device__ __forceinline__ unsigned zero_if_eq(unsigned k, unsigned M) { unsigned r; asm("v_cmp_ne_u32_e32 vcc, %1, %2\n\tv_cndmask_b32_e32 %0, 0, %1, vcc" : "=v"(r) : "v"(k), "v"(M) : "vcc"); return r; }
__device__ __forceinline__ void take_if_eq(unsigned& p, unsigned& k, unsigned M, unsigned pay) { unsigned nk; asm("v_cmp_eq_u32_e32 vcc, %2, %3\n\tv_cndmask_b32_e32 %0, %0, %4, vcc\n\tv_cndmask_b32_e64 %1, %2, 0, vcc" : "+v"(p), "=&v"(nk) : "v"(k), "v"(M), "v"(pay) : "vcc"); k = nk; }

#define SN_CE(k, a_, b_) do { const unsigned x_ = k[a_], y_ = k[b_]; k[a_] = x_ > y_ ? x_ : y_; k[b_] = x_ > y_ ? y_ : x_; } while (0)
template <int OFF, int N>
__device__ __forceinline__ void sn_sort16_desc(unsigned (&k)[N]) {
#pragma unroll
    for (int kk = 2; kk <= 16; kk <<= 1)
#pragma unroll
        for (int j = kk >> 1; j > 0; j >>= 1)
#pragma unroll
            for (int i = 0; i < 16; ++i) { const int l = i ^ j; if (l > i) { if ((i & kk) == 0) SN_CE(k, OFF + i, OFF + l); else SN_CE(k, OFF + l, OFF + i); } }
}
template <int OFF, int N>
__device__ __forceinline__ void sn_bmerge16_desc(unsigned (&k)[N]) {
#pragma unroll
    for (int j = 8; j > 0; j >>= 1)
#pragma unroll
        for (int i = 0; i < 16; ++i) { const int l = i ^ j; if (l > i) SN_CE(k, OFF + i, OFF + l); }
}
template <int A, int B, int N>
__device__ __forceinline__ void sn_merge16(unsigned (&k)[N]) {
#pragma unroll
    for (int i = 0; i < 16; ++i) { const unsigned x_ = k[A + i], y_ = k[B + 15 - i]; k[A + i] = x_ > y_ ? x_ : y_; }
    sn_bmerge16_desc<A>(k);
}

__device__ __forceinline__ void peer_route_unit(unsigned char* ws, LAS unsigned char* lds, int tile, int h, int wave, int lane, bool load_keys  ) {
    int tid = threadIdx.x; asm volatile("" : "+v"(tid)); const int r32 = lane & 31, hi = lane >> 5;
    constexpr int KSTR = 272;
    const bf16* keys = (const bf16*)(ws + WS_KEYS) + (size_t)h * 2 * 128 * 128;
    if (load_keys) {
        __syncthreads();
        for (int i = tid; i < 2 * 128 * 16; i += NTHR) { const int row = i >> 4, ch = i & 15; *(LAS v4u*)(lds + row * KSTR + ch * 16) = *(const GAS v4u*)(keys + (size_t)row * 128 + ch * 8); }
        __syncthreads();
    }
    const size_t tok = (size_t)tile * 256 + wave * 32 + r32;
    const bf16* q = (const bf16*)(ws + WS_QP) + tok * 2048 + h * 256;
    unsigned list[2][16];
#pragma unroll
    for (int p = 0; p < 2; ++p) {
        bf16x8 qf[8];
#pragma unroll
        for (int s = 0; s < 8; ++s) qf[s] = *(const GAS bf16x8*)(q + p * 128 + 16 * s + 8 * hi);
        unsigned key[64];
#pragma unroll
        for (int nb = 0; nb < 4; ++nb) {
            f32x16 acc;
#pragma unroll
            for (int r = 0; r < 16; ++r) acc[r] = 0.f;
            const LAS unsigned char* kb = lds + (p * 128 + 32 * nb + r32) * KSTR + hi * 16;
#pragma unroll
            for (int s = 0; s < 8; ++s) acc = __builtin_amdgcn_mfma_f32_32x32x16_bf16(*(const LAS bf16x8*)(kb + s * 32), qf[s], acc, 0, 0, 0);
#pragma unroll
            for (int r = 0; r < 16; ++r) { const int n = 32 * nb + crow(r, hi); key[nb * 16 + r] = (f2key(acc[r]) & ~127u) | (unsigned)(127 - n); }
        }
        sn_sort16_desc<0>(key); sn_sort16_desc<16>(key); sn_sort16_desc<32>(key); sn_sort16_desc<48>(key);
        sn_merge16<0, 16>(key); sn_merge16<32, 48>(key); sn_merge16<0, 32>(key);
        unsigned c16[16];
#pragma unroll
        for (int i = 0; i < 16; ++i) { const unsigned mine = key[15 - i]; auto rr = __builtin_amdgcn_permlane32_swap(mine, mine, false, false); const unsigned other = hi ? rr[0] : rr[1];
            c16[i] = key[i] > other ? key[i] : other; }
        sn_bmerge16_desc<0>(c16);
#pragma unroll
        for (int rd = 0; rd < 16; ++rd) list[p][rd] = c16[rd];
    }
    constexpr int CA[50] = {0,0,0,0,0,0,0,0,0,0,0,0,0,0,0,0, 1,1,1,1,1,1,1,1, 2,2,2,2,2, 3,3,3,3, 4,4,4, 5,5, 6,6, 7,7, 8,9,10,11,12,13,14,15};
    constexpr int CB[50] = {0,1,2,3,4,5,6,7,8,9,10,11,12,13,14,15, 0,1,2,3,4,5,6,7, 0,1,2,3,4, 0,1,2,3, 0,1,2, 0,1, 0,1, 0,1, 0,0,0,0,0,0,0,0};
    unsigned ck[50], pay[50];
#pragma unroll
    for (int c = 0; c < 50; ++c) { const unsigned ka = list[0][CA[c]], kb2 = list[1][CB[c]];
        const float s = key2f(ka & ~127u) + key2f(kb2 & ~127u);
        ck[c] = (f2key(s) & ~63u) | (unsigned)(63 - c); pay[c] = ((127u - (ka & 127u)) << 7) | (127u - (kb2 & 127u)); }
    float ss[16]; unsigned sp[16];
#pragma unroll
    for (int rd = 0; rd < 16; ++rd) {
        unsigned mx = ck[0];
#pragma unroll
        for (int c = 1; c < 50; ++c) mx = umax2(mx, ck[c]);
        unsigned pp = 0u;
#pragma unroll
        for (int c = 0; c < 50; ++c) take_if_eq(pp, ck[c], mx, pay[c]);
        ss[rd] = key2f(mx & ~63u); sp[rd] = pp;
    }
    float sum = 0.f;
    const float smax = ss[0];
#pragma unroll
    for (int k = 0; k < 16; ++k) { ss[k] = __expf(ss[k] - smax); sum += ss[k]; }
    const float inv = 1.f / sum;
    if (hi == 0) {
        int* pi = (int*)(ws + WS_PIDX) + tok * 128 + h * 16; float* pg = (float*)(ws + WS_PGATE) + tok * 128 + h * 16;
#pragma unroll
        for (int k = 0; k < 16; k += 4) { v4u iv; iv.x = sp[k]; iv.y = sp[k + 1]; iv.z = sp[k + 2]; iv.w = sp[k + 3]; *(GAS v4u*)(pi + k) = iv;
            f32x4 gv; gv.x = ss[k] * inv; gv.y = ss[k + 1] * inv; gv.z = ss[k + 2] * inv; gv.w = ss[k + 3] * inv; *(GAS f32x4*)(pg + k) = gv; }
    }
}

typedef unsigned v2u __attribute__((ext_vector_type(2)));
__device__ __forceinline__ void fp4_row(const f32x4 (&v)[4], unsigned char* dst, float* scale_out, int lane) {
    float amax = 0.f;
#pragma unroll
    for (int k = 0; k < 4; ++k) { amax = fmaxf(amax, fmaxf(fmaxf(fabsf(v[k].x), fabsf(v[k].y)), fmaxf(fabsf(v[k].z), fabsf(v[k].w)))); }
    amax = wave_max(amax);
    const float sc = amax > 0.f ? amax * (1.f / 6.f) : 1.f, inv = 1.f / sc;
    v2u w;
    { unsigned p = 0; p = __builtin_amdgcn_cvt_scalef32_pk_fp4_f32(p, v[0].x * inv, v[0].y * inv, 1.f, 0); p = __builtin_amdgcn_cvt_scalef32_pk_fp4_f32(p, v[0].z * inv, v[0].w * inv, 1.f, 1);
      p = __builtin_amdgcn_cvt_scalef32_pk_fp4_f32(p, v[1].x * inv, v[1].y * inv, 1.f, 2); p = __builtin_amdgcn_cvt_scalef32_pk_fp4_f32(p, v[1].z * inv, v[1].w * inv, 1.f, 3); w.x = p; }
    { unsigned p = 0; p = __builtin_amdgcn_cvt_scalef32_pk_fp4_f32(p, v[2].x * inv, v[2].y * inv, 1.f, 0); p = __builtin_amdgcn_cvt_scalef32_pk_fp4_f32(p, v[2].z * inv, v[2].w * inv, 1.f, 1);
      p = __builtin_amdgcn_cvt_scalef32_pk_fp4_f32(p, v[3].x * inv, v[3].y * inv, 1.f, 2); p = __builtin_amdgcn_cvt_scalef32_pk_fp4_f32(p, v[3].z * inv, v[3].w * inv, 1.f, 3); w.y = p; }
    *(GAS v2u*)(dst + 8 * lane) = w;
    if (lane == 0) *scale_out = sc;
}
__device__ __forceinline__ void fp4_row_nat(const f32x4 (&v)[4], unsigned char* dst, float* scale_out, int lane) {
    float amax = 0.f;
#pragma unroll
    for (int k = 0; k < 4; ++k) { amax = fmaxf(amax, fmaxf(fmaxf(fabsf(v[k].x), fabsf(v[k].y)), fmaxf(fabsf(v[k].z), fabsf(v[k].w)))); }
    amax = wave_max(amax);
    const float sc = amax > 0.f ? amax * (1.f / 6.f) : 1.f, inv = 1.f / sc;
#pragma unroll
    for (int k = 0; k < 4; ++k) { unsigned p = 0; p = __builtin_amdgcn_cvt_scalef32_pk_fp4_f32(p, v[k].x * inv, v[k].y * inv, 1.f, 0); p = __builtin_amdgcn_cvt_scalef32_pk_fp4_f32(p, v[k].z * inv, v[k].w * inv, 1.f, 1);
        *(GAS unsigned short*)(dst + 128 * k + 2 * lane) = (unsigned short)p; }
    if (lane == 0) *scale_out = sc;
}
__device__ __forceinline__ f32x2 dot8_fp4(unsigned q, const f32x2* x2, f32x2 acc) {
    const f32x2 a = __builtin_amdgcn_cvt_scalef32_pk_f32_fp4(q, 1.f, 0), b = __builtin_amdgcn_cvt_scalef32_pk_f32_fp4(q, 1.f, 1), c = __builtin_amdgcn_cvt_scalef32_pk_f32_fp4(q, 1.f, 2), d = __builtin_amdgcn_cvt_scalef32_pk_f32_fp4(q, 1.f, 3);
    acc = __builtin_elementwise_fma(a, x2[0], acc); acc = __builtin_elementwise_fma(b, x2[1], acc); acc = __builtin_elementwise_fma(c, x2[2], acc); acc = __builtin_elementwise_fma(d, x2[3], acc);
    return acc;
}
__device__ __forceinline__ void axpy8_fp4(float* o, float w, unsigned q) {
    const f32x2 a = __builtin_amdgcn_cvt_scalef32_pk_f32_fp4(q, 1.f, 0), b = __builtin_amdgcn_cvt_scalef32_pk_f32_fp4(q, 1.f, 1), c = __builtin_amdgcn_cvt_scalef32_pk_f32_fp4(q, 1.f, 2), d = __builtin_amdgcn_cvt_scalef32_pk_f32_fp4(q, 1.f, 3);
    o[0] += w * a.x; o[1] += w * a.y; o[2] += w * b.x; o[3] += w * b.y; o[4] += w * c.x; o[5] += w * c.y; o[6] += w * d.x; o[7] += w * d.y;
}
__device__ __forceinline__ void peer_token8(LAS unsigned char* xl  , unsigned char* ws, float* xio, const float* gffn, const float* lng, const float* lnb, const float* mod_next  , unsigned char* u8_next  , size_t tok, int lane) {
    const bf16* u2 = (const bf16*)(ws + WS_U2) + tok * 1024;
    float x[16];
#pragma unroll
    for (int k = 0; k < 4; ++k) { const unsigned long long w = *(const GAS unsigned long long*)(u2 + 256 * k + 4 * lane); const unsigned w0 = (unsigned)w, w1 = (unsigned)(w >> 32);
        x[4 * k] = bf_lo(w0); x[4 * k + 1] = bf_hi(w0); x[4 * k + 2] = bf_lo(w1); x[4 * k + 3] = bf_hi(w1); }
    f32x2 x2[8];
#pragma unroll
    for (int i = 0; i < 8; ++i) { x2[i].x = x[2 * i]; x2[i].y = x[2 * i + 1]; }
#pragma unroll
    for (int k = 0; k < 4; ++k) { int wd = __builtin_amdgcn_cvt_pk_fp8_f32(x[4 * k] * 2.f, x[4 * k + 1] * 2.f, 0, false); wd = __builtin_amdgcn_cvt_pk_fp8_f32(x[4 * k + 2] * 2.f, x[4 * k + 3] * 2.f, wd, true);
        *(LAS int*)(xl + 256 * k + 4 * lane) = wd; }
    const int* pi = (const int*)(ws + WS_PIDX) + tok * 128; const float* pg = (const float*)(ws + WS_PGATE) + tok * 128;
    const float* sus = (const float*)(ws + WS_TSCALE); const float* svs = sus + 16384;
    const int ia = pi[lane], ib = pi[64 + lane];
    const float ga = pg[lane] * svs[ia], gb = pg[64 + lane] * svs[ib];
    const float ua_s = sus[ia], ub_s = sus[ib];
    const unsigned char* vt = ws + WS_VTAB + 8 * lane;
    float out[16];
#pragma unroll
    for (int i = 0; i < 16; ++i) out[i] = 0.f;
    const int el = lane & 15, g4 = lane >> 4;
    typedef int v4i_t __attribute__((ext_vector_type(4))); typedef int v8i_t __attribute__((ext_vector_type(8)));
    v4i_t ua[8]; v2u qv[16];
#define PK_IDX(eb_) const int ebl_ = (eb_); const int srcl_ = ebl_ < 4 ? ia : ib; const int basel_ = (ebl_ & 3) * 16; int e_[16]; \
        _Pragma("unroll") for (int j = 0; j < 16; ++j) e_[j] = __builtin_amdgcn_readlane(srcl_, basel_ + j);
#define PK_LOADU(eb_) do { const int ebl_ = (eb_); const int mine_ = shl_i(ebl_ < 4 ? ia : ib, (ebl_ & 3) * 16 + el); const unsigned char* up_ = ws + WS_UTAB + (size_t)mine_ * 512 + 16 * g4; \
        _Pragma("unroll") for (int c = 0; c < 8; ++c) ua[c] = *(const GAS v4i_t*)(up_ + 64 * c); } while (0)
#define PK_LOADV(eb_) do { PK_IDX(eb_) _Pragma("unroll") for (int j = 0; j < 16; ++j) qv[j] = *(const GAS v2u*)(vt + (size_t)e_[j] * 512); } while (0)
    PK_LOADU(0);
#pragma unroll 1
    for (int eb = 0; eb < 8; ++eb) {
        const float gsrc = eb < 4 ? ga : gb, ssrc = eb < 4 ? ua_s : ub_s; const int base = (eb & 3) * 16;
        PK_LOADV(eb);
        f32x4 acc = {0.f, 0.f, 0.f, 0.f};
        int xo = 16 * g4; asm volatile("" : "+v"(xo));
#pragma unroll
        for (int c = 0; c < 8; ++c) { const v4i_t b0 = *(const LAS v4i_t*)(xl + xo + 128 * c), b1 = *(const LAS v4i_t*)(xl + xo + 128 * c + 64);
            const v8i_t av = {ua[c].x, ua[c].y, ua[c].z, ua[c].w, 0, 0, 0, 0}, bv = {b0.x, b0.y, b0.z, b0.w, b1.x, b1.y, b1.z, b1.w};
            acc = __builtin_amdgcn_mfma_scale_f32_16x16x128_f8f6f4(av, bv, acc, 4  , 0  , 0, 0x7F7F7F7F, 0, 0x7F7F7F7F); }
        const int isel = el & 3, je = 4 * g4 + isel;
        const float dsel = isel == 0 ? acc.x : isel == 1 ? acc.y : isel == 2 ? acc.z : acc.w;
        const float gate = shl_f(gsrc, base + je); const float hh = dsel * 0.5f * shl_f(ssrc, base + je);
        const float w = gate * 0.5f * hh * (1.f + erff(hh * 0.70710678118654752f));
        if (eb < 7) PK_LOADU(eb + 1);
#pragma unroll
        for (int j = 0; j < 16; ++j) { const float wj = __uint_as_float(__builtin_amdgcn_readlane(__float_as_uint(w), 16 * (j >> 2) + (j & 3)));
            axpy8_fp4(out, wj, qv[j].x); axpy8_fp4(out + 8, wj, qv[j].y); }
    }
#undef PK_LOADU
#undef PK_LOADV
#undef PK_IDX
    float* xr = xio + tok * 1024; f32x4 z[4]; float s = 0.f;
#pragma unroll
    for (int k = 0; k < 4; ++k) { const f32x4 xv = *(const GAS f32x4*)(xr + 256 * k + 4 * lane), gv = *(const GAS f32x4*)(gffn + 256 * k + 4 * lane);
        z[k].x = DN_ALPHA * xv.x + gv.x * out[4 * k]; z[k].y = DN_ALPHA * xv.y + gv.y * out[4 * k + 1]; z[k].z = DN_ALPHA * xv.z + gv.z * out[4 * k + 2]; z[k].w = DN_ALPHA * xv.w + gv.w * out[4 * k + 3];
        s += (z[k].x + z[k].y) + (z[k].z + z[k].w); }
    const float mean = wave_sum(s) * (1.f / DM); float s2 = 0.f;
#pragma unroll
    for (int k = 0; k < 4; ++k) { z[k] = z[k] - mean; s2 += (z[k].x * z[k].x + z[k].y * z[k].y) + (z[k].z * z[k].z + z[k].w * z[k].w); }
    const float rstd = 1.f / sqrtf(wave_sum(s2) * (1.f / DM) + LN_EPS);
    float s3 = 0.f;
#pragma unroll
    for (int k = 0; k < 4; ++k) { const f32x4 g = *(const GAS f32x4*)(lng + 256 * k + 4 * lane), bb = *(const GAS f32x4*)(lnb + 256 * k + 4 * lane);
        z[k] = z[k] * rstd * g + bb; *(GAS f32x4*)(xr + 256 * k + 4 * lane) = z[k]; s3 += (z[k].x + z[k].y) + (z[k].z + z[k].w); }
    if (mod_next) {
        const float mean3 = wave_sum(s3) * (1.f / DM); float s4 = 0.f;
#pragma unroll
        for (int k = 0; k < 4; ++k) { z[k] = z[k] - mean3; s4 += (z[k].x * z[k].x + z[k].y * z[k].y) + (z[k].z * z[k].z + z[k].w * z[k].w); }
        const float rstd3 = 1.f / sqrtf(wave_sum(s4) * (1.f / DM) + LN_EPS);
        GAS int* o4 = (GAS int*)(u8_next + tok * 1024) + lane;
#pragma unroll
        for (int k = 0; k < 4; ++k) { const f32x4 a = ((const GAS f32x4*)(mod_next + 1024))[lane + 64 * k], b = ((const GAS f32x4*)mod_next)[lane + 64 * k];
            f32x4 y = (z[k] * rstd3 * (a + 1.f) + b) * U8_SCALE; y.x = __builtin_amdgcn_fmed3f(y.x, -440.f, 440.f); y.y = __builtin_amdgcn_fmed3f(y.y, -440.f, 440.f); y.z = __builtin_amdgcn_fmed3f(y.z, -440.f, 440.f); y.w = __builtin_amdgcn_fmed3f(y.w, -440.f, 440.f);
            int wd = __builtin_amdgcn_cvt_pk_fp8_f32(y.x, y.y, 0, false); wd = __builtin_amdgcn_cvt_pk_fp8_f32(y.z, y.w, wd, true); o4[64 * k] = wd; }
    }
}

__device__ __forceinline__ void ln1_row(f32x4 (&v)[4], float* zrow, const float* g1, const float* b1, const float* sh, const float* sc, bf16* urow, int lane) {
    GAS f32x4* xr = (GAS f32x4*)zrow + lane;
    float s = 0.f;
#pragma unroll
    for (int j = 0; j < 4; ++j) { s += (v[j].x + v[j].y) + (v[j].z + v[j].w); }
    float mean = wave_sum(s) * (1.f / DM); float s2 = 0.f;
#pragma unroll
    for (int j = 0; j < 4; ++j) { v[j] = v[j] - mean; s2 += (v[j].x * v[j].x + v[j].y * v[j].y) + (v[j].z * v[j].z + v[j].w * v[j].w); }
    float rstd = 1.f / sqrtf(wave_sum(s2) * (1.f / DM) + LN_EPS);
    s = 0.f;
#pragma unroll
    for (int j = 0; j < 4; ++j) { const f32x4 g = ((const GAS f32x4*)g1)[lane + 64 * j], b = ((const GAS f32x4*)b1)[lane + 64 * j];
        v[j] = v[j] * rstd * g + b; xr[64 * j] = v[j]; s += (v[j].x + v[j].y) + (v[j].z + v[j].w); }
    mean = wave_sum(s) * (1.f / DM); s2 = 0.f;
#pragma unroll
    for (int j = 0; j < 4; ++j) { v[j] = v[j] - mean; s2 += (v[j].x * v[j].x + v[j].y * v[j].y) + (v[j].z * v[j].z + v[j].w * v[j].w); }
    rstd = 1.f / sqrtf(wave_sum(s2) * (1.f / DM) + LN_EPS);
    GAS unsigned long long* o8 = (GAS unsigned long long*)urow + lane;
#pragma unroll
    for (int j = 0; j < 4; ++j) { const f32x4 a = ((const GAS f32x4*)sc)[lane + 64 * j], b = ((const GAS f32x4*)sh)[lane + 64 * j];
        const f32x4 y = v[j] * rstd * (a + 1.f) + b;
        o8[64 * j] = (unsigned long long)pk2(y.x, y.y) | ((unsigned long long)pk2(y.z, y.w) << 32); }
}

#ifndef MK_MULTI
#define MK_MULTI 0
#endif
struct Args { const float* in[27]; float* out; unsigned char* ws; float inv64[32]; float inv32[16]; int ph_lo, ph_hi; };

__global__ void __launch_bounds__(NTHR, 2) fwd_kernel(Args args) {
    extern __shared__ __attribute__((aligned(16))) unsigned char lds_raw[];
    LAS unsigned char* lds = (LAS unsigned char*)lds_raw;
    volatile LAS unsigned* MISC = (volatile LAS unsigned*)(lds + MISC_OFF);
#define CAS __attribute__((address_space(4)))
#define PHASE_IDS const CAS Args* ka_ = (const CAS Args*)__builtin_amdgcn_kernarg_segment_ptr(); asm volatile("" : "+s"(ka_)); Ptrs P; \
    _Pragma("unroll") for (int i_ = 0; i_ < 27; ++i_) P.in[i_] = ka_->in[i_]; P.out = ka_->out; P.ws = ka_->ws; unsigned char* ws = P.ws; (void)ws; \
    int G = gridDim.x, bx = blockIdx.x; asm volatile("" : "+s"(G), "+s"(bx));   \
    const int vcu = (G % 8 == 0) ? (bx % 8) * (G / 8) + bx / 8 : bx;     \
    const int NGW = G * NWAVES; (void)NGW; \
    int tid = threadIdx.x; asm volatile("" : "+v"(tid)); const int lane = tid & 63, wave = __builtin_amdgcn_readfirstlane(tid >> 6); const int gw = vcu * NWAVES + wave; (void)lane; (void)gw;
    gu32* ctl = (gu32*)(args.ws + WS_CTL);
    for (int u = threadIdx.x; u < (LDS_BYTES - LDSCTL_OFF) / 4; u += NTHR) ((LAS unsigned*)(lds + LDSCTL_OFF))[u] = 0u;
    __syncthreads();
    const int lo = args.ph_lo, hi_ph = args.ph_hi;
    XcdBarrier bar; bar.bar = (unsigned*)(ctl + CW_BAR); bar.x = 0; bar.st = nullptr;
    if (hi_ph - lo > 1) bar = xcd_barrier_post((unsigned*)(ctl + CW_BAR), MISC + 8);
#ifndef PHASE_MASK
#define PHASE_MASK 0xFFF
#endif
#ifndef FL_VAR
#define FL_VAR 0
#endif
#ifndef FL_VAR_KINDS
#define FL_VAR_KINDS 3
#endif
#ifndef DUP_MASK
#define DUP_MASK 0
#endif
#ifndef ATT_MASK
#define ATT_MASK 15
#endif
#define PHON(j) (((PHASE_MASK) >> (j)) & 1)
#define IN(k) (lo <= (k) && (k) < hi_ph)
#define SEAM(k) do { if (IN(k) && IN((k) + 1)) xcd_barrier(bar); } while (0)

    if (PHON(11) && IN(0)) { PHASE_IDS
        compute_mod(P, lds, tid);
        compute_rope(P, (const float*)ka_->inv64, (const float*)ka_->inv32, vcu * NTHR + tid, G * NTHR);
        convert_weights(P, 0, lds, gw, NGW, wave, lane);
    }
    SEAM(0);

#pragma unroll
    for (int l = 0; l < DEPTH; ++l) {
        const int pb = 1 + 11 * l;
#define xin ((l == 0) ? P.in[0] : (const float*)P.out)
#define modl ((const float*)(ws + WS_MOD) + (size_t)l * 4 * 6144)
        if (PHON(0) && IN(pb + 0)) { PHASE_IDS
            if (l > 0) convert_weights(P, l, lds, gw, NGW, wave, lane);
            if (l == 0) for (int m = gw; m < T; m += NGW) { const float* mb = modl + (size_t)(m / SEQ) * 6144; f32x4 cur[4]; load_row(cur, xin + (size_t)m * DM, lane);
                ln_mod_row(cur, mb, mb + 1024, ws + WS_U + (size_t)m * DM, lane); }
        }
        SEAM(pb + 0);
        for (int rep_ = 0; rep_ < ((DUP_MASK >> 0) & 1) + 1; ++rep_) {
        if (PHON(1) && IN(pb + 1)) { PHASE_IDS
            pg8::Gemm g{(const bf16*)(ws + WS_U + (size_t)(l & 1) * 32 * MiB), (const bf16*)(ws + WS_WIN), T, NIN, 512, 512, 512}; pg8::StaticOrder S; S.init(T, NIN, G, bx);
            EpiInProj E{ws};
            pg8::gemm_phase<true>(lds, g, S, E);
        }
        SEAM(pb + 1);
        if (PHON(2) && IN(pb + 2)) { PHASE_IDS
            float* rstd = (float*)(ws + WS_RSTD);
            for (int m = gw; m < T; m += NGW) {
                const bf16* row = (const bf16*)(ws + WS_LAT) + (size_t)m * 768;
                float sq = 0.f, skv = 0.f;
                if (lane < 48) { const v4u a = *(const GAS v4u*)(row + 8 * lane);
                    sq = bf_lo(a.x) * bf_lo(a.x) + bf_hi(a.x) * bf_hi(a.x) + bf_lo(a.y) * bf_lo(a.y) + bf_hi(a.y) * bf_hi(a.y) + bf_lo(a.z) * bf_lo(a.z) + bf_hi(a.z) * bf_hi(a.z) + bf_lo(a.w) * bf_lo(a.w) + bf_hi(a.w) * bf_hi(a.w); }
                if (lane < 32) { const v4u a = *(const GAS v4u*)(row + 384 + 8 * lane);
                    skv = bf_lo(a.x) * bf_lo(a.x) + bf_hi(a.x) * bf_hi(a.x) + bf_lo(a.y) * bf_lo(a.y) + bf_hi(a.y) * bf_hi(a.y) + bf_lo(a.z) * bf_lo(a.z) + bf_hi(a.z) * bf_hi(a.z) + bf_lo(a.w) * bf_lo(a.w) + bf_hi(a.w) * bf_hi(a.w); }
                sq = wave_sum(sq); skv = wave_sum(skv);
                if (lane == 0) { rstd[2 * m] = 1.f / sqrtf(sq * (1.f / 384.f) + LN_EPS); rstd[2 * m + 1] = 1.f / sqrtf(skv * (1.f / 256.f) + LN_EPS); }
            }
        }
        SEAM(pb + 2);
        if (PHON(3) && IN(pb + 3)) { PHASE_IDS
            if (ATT_MASK & 1) { pg8::Gemm g{(const bf16*)(ws + WS_LAT), (const bf16*)(ws + WS_QUP), T, 768, 384, 768, 384}; pg8::StaticOrder S; S.init(T, 768, G, bx);
              EpiQup E{ws}; pg8::gemm_phase<false>(lds, g, S, E); }
            if (ATT_MASK & 2) { pg8::Gemm g{(const bf16*)(ws + WS_LAT) + 384, (const bf16*)(ws + WS_KVUP), T, 1024, 256, 768, 256}; pg8::StaticOrder S; S.init(T, 1024, G, bx);
              EpiScaleRow E{(bf16*)(ws + WS_KVB), 1024, (const float*)(ws + WS_RSTD) + 1, 2, 512, ws + WS_DIFV + 16 * MiB}; pg8::gemm_phase<false>(lds, g, S, E); }
        }
        SEAM(pb + 3);
        if (PHON(4) && IN(pb + 4)) { PHASE_IDS
            LAS float* bias_all = (LAS float*)(lds + LDSCTL_OFF + 1024);
            for (int i = tid; i < 8 * 465; i += NTHR) bias_all[i] = P.in[15][(size_t)l * 3720 + i] * LOG2E;
            const float lam_init = 0.8f - 0.6f * expf(-0.3f * (float)l);
            __syncthreads();
#if FL_VAR
            if (rep_ == 0 && DUP_MASK) {
                if (FL_VAR_KINDS & 1) for (int u = vcu; u < 16 * 32; u += G) { const int bh = u >> 5; diff_unit<FL_VAR>(ws, lds, bh >> 2, bh & 3, u & 31, wave, lane, P.in[10] + l * 64, P.in[11] + l * 64, P.in[12] + l * 64, P.in[13] + l * 64, lam_init, P.in[14] + l * 128); }
                if (FL_VAR_KINDS & 2) for (int u = vcu; u < 32 * 32; u += G) { const int bh = u >> 5; mla_unit<FL_VAR>(ws, lds, bh >> 3, bh & 7, u & 31, (l + 1) & 1, lane); }
                if (FL_VAR_KINDS & 4) for (int u = vcu; u < 32 * 32; u += G) { const int bh = u >> 5; swa_unit(ws, lds, bh >> 3, bh & 7, u & 31, (l + 1) & 1, lane, P.in[5][l * 8 + (bh & 7)] * LOG2E); }
                if (FL_VAR_KINDS & 8) for (int u = vcu; u < 32 * 32; u += G) { const int bh = u >> 5; nat_unit(ws, lds, bias_all, bh >> 3, bh & 7, u & 31, wave, lane); }
            } else {
#endif
            if (ATT_MASK & 1) for (int u = vcu; u < 16 * 32; u += G) { const int bh = u >> 5; diff_unit(ws, lds, bh >> 2, bh & 3, u & 31, wave, lane, P.in[10] + l * 64, P.in[11] + l * 64, P.in[12] + l * 64, P.in[13] + l * 64, lam_init, P.in[14] + l * 128); }
            if (ATT_MASK & 2) for (int u = vcu; u < 32 * 32; u += G) { const int bh = u >> 5; mla_unit(ws, lds, bh >> 3, bh & 7, u & 31, (l + 1) & 1, lane); }
            if (ATT_MASK & 4) for (int u = vcu; u < 32 * 32; u += G) { const int bh = u >> 5; swa_unit(ws, lds, bh >> 3, bh & 7, u & 31, (l + 1) & 1, lane, P.in[5][l * 8 + (bh & 7)] * LOG2E); }
            if (ATT_MASK & 8) for (int u = vcu; u < 32 * 32; u += G) { const int bh = u >> 5; nat_unit(ws, lds, bias_all, bh >> 3, bh & 7, u & 31, wave, lane); }
#if FL_VAR
            }
#endif
        }
        SEAM(pb + 4);
        }
        for (int rep_ = 0; rep_ < ((DUP_MASK >> 1) & 1) + 1; ++rep_) {
        if (PHON(5) && IN(pb + 5)) { PHASE_IDS
            for (int n = 0; n < 4; ++n) {
                { pg8::Gemm g{(const bf16*)(ws + WS_U + (size_t)(l & 1) * 32 * MiB), (const bf16*)(ws + WS_WG + (size_t)n * 1024 * 1024), T, 1024, 512, 512, 512}; pg8::StaticOrder S; S.init(T, 1024, G, bx);
                  EpiSigmoid E{ws + WS_SG}; pg8::gemm_phase<true>(lds, g, S, E); }
                const size_t ob = (n < 2) ? WS_U + (size_t)((l + 1) & 1) * 32 * MiB + (size_t)n * 16 * MiB : WS_LAT + (size_t)(n - 2) * 512;
                { pg8::Gemm g{(const bf16*)(ws + ob), (const bf16*)(ws + WS_WB + (size_t)n * 1024 * 512), T, 1024, 256, (n < 2) ? 256 : 768, 256}; pg8::StaticOrder S; S.init(T, 1024, G, bx);
                  EpiGated E{ws + WS_SG, ws + WS_SG + 32 * MiB, ws + WS_MERGED, n}; pg8::gemm_phase<true>(lds, g, S, E); }
            }
        }
        SEAM(pb + 5);
        }
        if (PHON(6) && IN(pb + 6)) { PHASE_IDS
            pg8::Gemm g{(const bf16*)(ws + WS_MERGED), (const bf16*)(ws + WS_WO), T, 1024, 512, 512, 512}; pg8::StaticOrder S; S.init(T, 1024, G, bx);
            EpiResid E{xin, P.out, modl + 2048}; pg8::gemm_phase<true>(lds, g, S, E);
        }
        SEAM(pb + 6);
        if (PHON(7) && IN(pb + 7)) { PHASE_IDS
            for (int m = gw; m < T; m += NGW) { const float* mb = modl + (size_t)(m / SEQ) * 6144; f32x4 cur[4]; load_row(cur, P.out + (size_t)m * DM, lane);
                ln1_row(cur, P.out + (size_t)m * DM, P.in[19] + l * 1024, P.in[20] + l * 1024, mb + 3072, mb + 4096, (bf16*)(ws + WS_U2) + (size_t)m * DM, lane); }
            const float* su = P.in[23] + (size_t)l * 16384 * 1024; const float* sv = P.in[24] + (size_t)l * 16384 * 1024;
            for (int r = gw; r < 2 * 16384; r += NGW) { const int tab = r >> 14, row = r & 16383; f32x4 cur[4]; load_row(cur, (tab ? sv : su) + (size_t)row * 1024, lane);
                if (tab) fp4_row(cur, ws + WS_VTAB + (size_t)row * 512, (float*)(ws + WS_TSCALE) + r, lane); else fp4_row_nat(cur, ws + WS_UTAB + (size_t)row * 512, (float*)(ws + WS_TSCALE) + r, lane); }
        }
        SEAM(pb + 7);
        for (int rep_ = 0; rep_ < ((DUP_MASK >> 2) & 1) + 1; ++rep_) {
        if (PHON(8) && IN(pb + 8)) { PHASE_IDS
            pg8::Gemm g{(const bf16*)(ws + WS_U2), (const bf16*)(ws + WS_WQ), T, 2048, 1024, 1024, 1024}; pg8::StaticOrder S; S.init(T, 2048, G, bx);
            EpiScaleRow E{(bf16*)(ws + WS_QP), 2048, nullptr, 0}; pg8::gemm_phase<false>(lds, g, S, E);
        }
        SEAM(pb + 8);
        if (PHON(9) && IN(pb + 9)) { PHASE_IDS
            { int last_h = -1; for (int u = vcu; u < (T / 256) * 8; u += G) { peer_route_unit(ws, lds, u >> 3, u & 7, wave, lane, (u & 7) != last_h); last_h = u & 7; } }
        }
        SEAM(pb + 9);
        }
        if (PHON(10) && IN(pb + 10)) { PHASE_IDS
            for (int m = gw; m < T; m += NGW) peer_token8(lds + wave * 1024, ws, P.out, modl + (size_t)(m / SEQ) * 6144 + 5120, P.in[25] + l * 1024, P.in[26] + l * 1024,
                                                       (l + 1 < DEPTH) ? modl + (size_t)(4 + m / SEQ) * 6144 : nullptr, ws + WS_U + (size_t)((l + 1) & 1) * 32 * MiB, (size_t)m, lane);
        }
        SEAM(pb + 10);
    }
#undef xin
#undef modl
#undef IN
#undef SEAM
}

extern "C" void kernel_launch(void* const* d_in, const int* in_sizes, int n_in, void* d_out, int out_size, void* d_ws, size_t ws_size, hipStream_t stream) {
    static int grid = 0;
    if (grid == 0) {
        if (n_in != 27 || out_size != T * DM || ws_size < WS_END) { fprintf(stderr, "kernel_launch: unexpected problem (n_in %d, out %d, ws %zu < %zu?)\n", n_in, out_size, ws_size, (size_t)WS_END); grid = -1; return; }
        int dev = 0, cus = 0, per_cu = 0;
        if (hipGetDevice(&dev) != hipSuccess || hipDeviceGetAttribute(&cus, hipDeviceAttributeMultiprocessorCount, dev) != hipSuccess) { grid = -1; return; }
        if (hipFuncSetAttribute((const void*)fwd_kernel, hipFuncAttributeMaxDynamicSharedMemorySize, LDS_BYTES) != hipSuccess) { fprintf(stderr, "kernel_launch: hipFuncSetAttribute failed\n"); grid = -1; return; }
        if (hipOccupancyMaxActiveBlocksPerMultiprocessor(&per_cu, (const void*)fwd_kernel, NTHR, LDS_BYTES) != hipSuccess || per_cu < 1) { fprintf(stderr, "kernel_launch: occupancy query says %d\n", per_cu); }
        (void)hipGetLastError();
        grid = cus < 256 ? cus : 256;
        fprintf(stderr, "kernel_launch: grid %d, ws %zu MiB\n", grid, ws_size >> 20);
    }
    if (grid < 0) return;
    (void)hipMemsetAsync((char*)d_ws + WS_CTL, 0, CTL_ZERO_BYTES, stream);
    Args a{};
    for (int i = 0; i < 27; ++i) a.in[i] = (const float*)d_in[i];
    a.out = (float*)d_out; a.ws = (unsigned char*)d_ws;
    for (int i = 0; i < 32; ++i) a.inv64[i] = (float)pow(10000.0, -(double)(2 * i) / 64.0);
    for (int i = 0; i < 16; ++i) a.inv32[i] = (float)pow(10000.0, -(double)(2 * i) / 32.0);
#if MK_MULTI
    for (int k = 0; k < NPHASE; ++k) { a.ph_lo = k; a.ph_hi = k + 1; hipLaunchKernelGGL(fwd_kernel, dim3(grid), dim3(NTHR), LDS_BYTES, stream, a); }
#else
    a.ph_lo = 0; a.ph_hi = NPHASE; hipLaunchKernelGGL(fwd_kernel, dim3(grid), dim3(NTHR), LDS_BYTES, stream, a);
#endif
}
```

```cpp
#include <hip/hip_runtime.h>
#include <cstdio>
#include <cstdint>
#include <cmath>

namespace pg8 {
#define PG8_LAS __attribute__((address_space(3)))
typedef unsigned short bf16_t;
typedef short bf16x8 __attribute__((ext_vector_type(8)));
typedef float f32x4 __attribute__((ext_vector_type(4)));
typedef unsigned u32x4 __attribute__((ext_vector_type(4)));
typedef long i64x2 __attribute__((ext_vector_type(2)));
typedef int i32x4 __attribute__((ext_vector_type(4)));
typedef int i32x8 __attribute__((ext_vector_type(8)));
constexpr int BM = 256, BK = 64, HALF = 128, HTB = HALF * BK * 2  , STAGE_BYTES = 8 * HTB, NXCD = 8, WGM = 8;

__host__ __device__ __forceinline__ int lds_byte(int r, int c) { const int st = (r >> 4) * 2 + (c >> 5), rr = r & 15, cc = c & 31, ob = rr * 64 + cc * 2; return st * 1024 + (ob ^ (((ob >> 9) & 1) << 5)); }
__host__ __device__ __forceinline__ void stage_rc(int b, int& R, int& C) { const int st = b / 1024, sb = b % 1024, swz = sb ^ (((sb >> 9) & 1) << 5); R = (st >> 1) * 16 + swz / 64; C = (st & 1) * 32 + (swz % 64) / 2; }
__host__ __device__ __forceinline__ int perm32(int rho) { const int n = rho >> 4, i = rho & 15; return 8 * (i >> 2) + 4 * n + (i & 3); }

struct Unit { int pm, pn; };
struct Gemm { const bf16_t* A; const bf16_t* Bt; int M, N, K, lda, ldb; };

struct StaticOrder {
    int nM, nN, nwg, G, c;
    __host__ __device__ void init(int M, int N, int G_, int c_) { nM = M / BM; nN = N / BM; nwg = nM * nN; G = G_; c = c_; }
    __host__ __device__ bool next(int i, Unit& u) const {
        const long L = (long)i * G + c; if (L >= nwg) return false;
        int wgid = (int)L; { const int q = nwg / NXCD, r = nwg % NXCD, xcd = wgid % NXCD, off = wgid / NXCD; wgid = (xcd < r ? xcd * (q + 1) : r * (q + 1) + (xcd - r) * q) + off; }
        const int nig = WGM * nN, gid = wgid / nig, fm = gid * WGM, gsz = (nM - fm) < WGM ? (nM - fm) : WGM;
        u.pm = fm + ((wgid % nig) % gsz); u.pn = (wgid % nig) / gsz; return true;
    }
};

__device__ __forceinline__ unsigned cvt_pk_bf16(float lo, float hi) { unsigned r; asm volatile("v_cvt_pk_bf16_f32 %0, %1, %2" : "=v"(r) : "v"(lo), "v"(hi)); return r; }

template <bool F8, class Epi, class Sched>
__device__ __forceinline__ void gemm_phase(PG8_LAS unsigned char* lds, const Gemm g, const Sched& S, Epi& E) {
    int tid = threadIdx.x; asm volatile("" : "+v"(tid));
    const int wid = __builtin_amdgcn_readfirstlane(tid >> 6), lane = tid & 63, wr = wid >> 2, wc = wid & 3, fr = lane & 15, fq = lane >> 4;
    const int K = g.K, nt = K / BK;
    unsigned voffA[2], voffB[2];
#pragma unroll
    for (int i = 0; i < 2; ++i) { int R, C; stage_rc(tid * 16 + i * 8192, R, C); const int Rb = (R & ~31) + perm32(R & 31);
        voffA[i] = (unsigned)(R * g.lda + C) * 2u; voffB[i] = (unsigned)(Rb * g.ldb + C) * 2u; }
    const size_t kstep = (size_t)(BK * 2);
    const size_t hstepA = (size_t)HALF * g.lda * 2, hstepB = (size_t)HALF * g.ldb * 2;
    const size_t tstepA = 2 * hstepA, tstepB = 2 * hstepB;
    const unsigned ldsw = (unsigned)wid * 1024u;
    const int aoff = lds_byte(wr * 64 + fr, fq * 8), boff = lds_byte(wc * 32 + fr, fq * 8);
#define PG8_SA(b, h) (((b) * 2 + (h)) * HTB)
#define PG8_SB(b, h) ((4 + (b) * 2 + (h)) * HTB)
#define PG8_STAGE(bufoff, gbase, voff) do { _Pragma("unroll") for (int _i = 0; _i < 2; ++_i) \
        __builtin_amdgcn_global_load_lds((const unsigned*)((const char*)(gbase) + (voff)[_i]), (PG8_LAS unsigned*)(lds + (bufoff) + ldsw + _i * 8192), 16, 0, 0); } while (0)
#define PG8_LDA(dst, b, h) do { _Pragma("unroll") for (int m = 0; m < 4; ++m) _Pragma("unroll") for (int k = 0; k < 2; ++k) dst[m][k] = *(const PG8_LAS bf16x8*)(lds + PG8_SA(b, h) + aoff + m * 2048 + k * 1024); } while (0)
#define PG8_LDB(dst, b, h) do { _Pragma("unroll") for (int n = 0; n < 2; ++n) _Pragma("unroll") for (int k = 0; k < 2; ++k) dst[n][k] = *(const PG8_LAS bf16x8*)(lds + PG8_SB(b, h) + boff + n * 2048 + k * 1024); } while (0)
#define PG8_MMA(ai, bj, At, Bt) do { __builtin_amdgcn_s_setprio(1); _Pragma("unroll") for (int m = 0; m < 4; ++m) _Pragma("unroll") for (int n = 0; n < 2; ++n) _Pragma("unroll") for (int k = 0; k < 2; ++k) { \
        if constexpr (F8) { if (k == 0) { const i32x4 b0_ = __builtin_bit_cast(i32x4, Bt[n][0]), b1_ = __builtin_bit_cast(i32x4, Bt[n][1]), a0_ = __builtin_bit_cast(i32x4, At[m][0]), a1_ = __builtin_bit_cast(i32x4, At[m][1]); \
            const i32x8 bb_ = {b0_.x, b0_.y, b0_.z, b0_.w, b1_.x, b1_.y, b1_.z, b1_.w}, aa_ = {a0_.x, a0_.y, a0_.z, a0_.w, a1_.x, a1_.y, a1_.z, a1_.w}; \
            asm volatile("v_mfma_scale_f32_16x16x128_f8f6f4 %0, %1, %2, %0, %3, %3 op_sel_hi:[0,0,0]" : "+v"(acc[ai][bj][m][n]) : "v"(bb_), "v"(aa_), "v"(0x7F7F7F7F)); } } \
        else acc[ai][bj][m][n] = __builtin_amdgcn_mfma_f32_16x16x32_bf16(Bt[n][k], At[m][k], acc[ai][bj][m][n], 0, 0, 0); } \
        __builtin_amdgcn_s_setprio(0); } while (0)
#define PG8_WAIT_V(n) asm volatile("s_waitcnt vmcnt(" #n ")" ::: "memory")
#define PG8_WAIT_L(n) asm volatile("s_waitcnt lgkmcnt(" #n ")" ::: "memory")
#define PG8_BAR __builtin_amdgcn_s_barrier()
#define PG8_SCHED __builtin_amdgcn_sched_barrier(0)
    Unit cur, nxt; int ui = 0;
    if (!S.next(0, cur)) return;
    f32x4 acc[2][2][4][2];
#pragma unroll
    for (int a = 0; a < 2; ++a)
#pragma unroll
        for (int b = 0; b < 2; ++b)
#pragma unroll
            for (int m = 0; m < 4; ++m)
#pragma unroll
                for (int n = 0; n < 2; ++n) acc[a][b][m][n] = (f32x4){0.f, 0.f, 0.f, 0.f};
    bf16x8 At[4][2], B0[2][2], B1[2][2];
    const char* cA = (const char*)g.A + (size_t)cur.pm * tstepA; const char* cB = (const char*)g.Bt + (size_t)cur.pn * tstepB;
    PG8_STAGE(PG8_SB(0, 0), cB, voffB); PG8_STAGE(PG8_SB(0, 1), cB + hstepB, voffB); PG8_STAGE(PG8_SA(0, 0), cA, voffA); PG8_STAGE(PG8_SA(0, 1), cA + hstepA, voffA);
    if (wr == 1) PG8_BAR;
    PG8_WAIT_V(2); PG8_BAR;
    PG8_STAGE(PG8_SB(1, 0), cB + kstep, voffB); PG8_STAGE(PG8_SA(1, 0), cA + kstep, voffA); PG8_STAGE(PG8_SB(1, 1), cB + hstepB + kstep, voffB);
    PG8_WAIT_V(6); PG8_BAR;
    for (;;) {
        const bool has_next = S.next(ui + 1, nxt);
        const char* nA = has_next ? (const char*)g.A + (size_t)nxt.pm * tstepA : cA; const char* nB = has_next ? (const char*)g.Bt + (size_t)nxt.pn * tstepB : cB;
#pragma unroll 1
        for (int t = 0; t < nt; t += 2) {
            const bool last = (t == nt - 2);
            const char* a1 = cA + (size_t)(t + 1) * kstep;
            const char* a2 = last ? nA : cA + (size_t)(t + 2) * kstep; const char* b2 = last ? nB : cB + (size_t)(t + 2) * kstep;
            const char* a3 = a2 + kstep; const char* b3 = b2 + kstep;
            PG8_LDB(B0, 0, 0); PG8_LDB(B1, 0, 1); PG8_SCHED; PG8_LDA(At, 0, 0); PG8_STAGE(PG8_SA(1, 1), a1 + hstepA, voffA);
            PG8_WAIT_V(8); PG8_WAIT_L(0); PG8_BAR; PG8_MMA(0, 0, At, B0); PG8_MMA(0, 1, At, B1); PG8_BAR; PG8_SCHED;
            PG8_LDA(At, 0, 1); PG8_STAGE(PG8_SB(0, 0), b2, voffB); PG8_STAGE(PG8_SB(0, 1), b2 + hstepB, voffB); PG8_STAGE(PG8_SA(0, 0), a2, voffA);
            PG8_WAIT_V(8); PG8_WAIT_L(0); PG8_BAR; PG8_MMA(1, 0, At, B0); PG8_MMA(1, 1, At, B1); PG8_BAR; PG8_SCHED;
            PG8_LDB(B0, 1, 0); PG8_LDB(B1, 1, 1); PG8_SCHED; PG8_LDA(At, 1, 0); PG8_STAGE(PG8_SA(0, 1), a2 + hstepA, voffA);
            PG8_WAIT_V(8); PG8_WAIT_L(0); PG8_BAR; PG8_MMA(0, 0, At, B0); PG8_MMA(0, 1, At, B1); PG8_BAR; PG8_SCHED;
            PG8_LDA(At, 1, 1); PG8_STAGE(PG8_SB(1, 0), b3, voffB); PG8_STAGE(PG8_SB(1, 1), b3 + hstepB, voffB); PG8_STAGE(PG8_SA(1, 0), a3, voffA);
            PG8_WAIT_V(8); PG8_WAIT_L(0); PG8_BAR; PG8_MMA(1, 0, At, B0); PG8_MMA(1, 1, At, B1); PG8_BAR; PG8_SCHED;
        }
        if (wr == 0) PG8_BAR;
        if constexpr (F8) asm volatile("s_nop 7\n\ts_nop 7\n\ts_nop 7" ::: "memory");
        E(acc, cur, wr, wc, fr, fq);
        if (!has_next) break;
#pragma unroll
        for (int a = 0; a < 2; ++a)
#pragma unroll
            for (int b = 0; b < 2; ++b)
#pragma unroll
                for (int m = 0; m < 4; ++m)
#pragma unroll
                    for (int n = 0; n < 2; ++n) acc[a][b][m][n] = (f32x4){0.f, 0.f, 0.f, 0.f};
        cur = nxt; cA = nA; cB = nB; ++ui;
        if (wr == 1) PG8_BAR;
    }
    PG8_WAIT_V(0);
    PG8_BAR;
#undef PG8_SA
#undef PG8_SB
#undef PG8_STAGE
#undef PG8_LDA
#undef PG8_LDB
#undef PG8_MMA
#undef PG8_WAIT_V
#undef PG8_WAIT_L
#undef PG8_BAR
#undef PG8_SCHED
}
}

constexpr int BATCH = 4, SEQ = 8192, T = BATCH * SEQ, DM = 1024, DEPTH = 2;
constexpr int NWAVES = 8, NTHR = 512;
constexpr float LN_EPS = 1e-5f;
constexpr float DN_ALPHA = 1.4142135623730951f;
constexpr float LOG2E = 1.4426950408889634f;
constexpr int D_IN = 4512, NIN = 4608;
constexpr float C_D64 = 0.125f * LOG2E;
constexpr float C_MLA = 0.10206207261596577f * LOG2E;
constexpr int NPHASE = 1 + 11 * DEPTH;

constexpr size_t MiB = 1u << 20;
constexpr size_t WS_CTL = 0, CTL_ZERO_BYTES = 1 * MiB;
constexpr size_t WS_MOD = 1 * MiB;
constexpr size_t WS_ROPE64 = 2 * MiB;
constexpr size_t WS_ROPE32 = 4 * MiB;
constexpr size_t WS_RSTD = 5 * MiB;
constexpr size_t WS_WIN = 6 * MiB;
constexpr size_t WS_WG = 15 * MiB;
constexpr size_t WS_WB = 23 * MiB;
constexpr size_t WS_WO = 27 * MiB;
constexpr size_t WS_WQ = 29 * MiB;
constexpr size_t WS_QUP = 33 * MiB;
constexpr size_t WS_KVUP = 34 * MiB;
constexpr size_t WS_KEYS = 35 * MiB;
constexpr size_t WS_U = 36 * MiB;
constexpr size_t WS_SWAQ = 100 * MiB;
constexpr size_t WS_SWAKV = 132 * MiB;
constexpr size_t WS_LAT = 148 * MiB;
constexpr size_t WS_DIFQ = 196 * MiB;
constexpr size_t WS_DIFK = 228 * MiB;
constexpr size_t WS_DIFV = 260 * MiB;
constexpr size_t WS_NATQ = 292 * MiB;
constexpr size_t WS_NATK = 324 * MiB;
constexpr size_t WS_NATV = 356 * MiB;
constexpr size_t WS_MQN = 388 * MiB;
constexpr size_t WS_MQR = 420 * MiB;
constexpr size_t WS_KVB = 436 * MiB;
constexpr size_t WS_DSCR = 500 * MiB;
constexpr size_t WS_END = 516 * MiB;
constexpr size_t WS_SG = WS_NATK;
constexpr size_t WS_MERGED = WS_DIFK;
constexpr size_t WS_U2 = WS_DIFK;
constexpr size_t WS_QP = WS_SWAQ;
constexpr size_t WS_PIDX = WS_NATQ;
constexpr size_t WS_PGATE = WS_NATQ + 16 * MiB;
constexpr size_t WS_UTAB = WS_KVB;
constexpr size_t WS_VTAB = WS_KVB + 32 * MiB;
constexpr size_t WS_TSCALE = WS_KVB + 63 * MiB;
constexpr int CW_BAR = 4096;

constexpr int RING_BYTES = 131072;
constexpr int LDSCTL_OFF = RING_BYTES, MISC_OFF = LDSCTL_OFF + 320;
constexpr int LDS_BYTES = 147456;
constexpr float U8_SCALE = 4.f, W8_SCALE = 64.f, UW8_INV = 1.f / (U8_SCALE * W8_SCALE);
constexpr float O8_SCALE = 16.f;
#define GAS __attribute__((address_space(1)))
#define LAS __attribute__((address_space(3)))
typedef unsigned short bf16;
typedef unsigned v4u __attribute__((ext_vector_type(4)));
typedef float f32x4 __attribute__((ext_vector_type(4)));
typedef short bf16x8 __attribute__((ext_vector_type(8)));
typedef GAS unsigned gu32;
typedef GAS unsigned long long gu64;
#define RLX_AGENT __ATOMIC_RELAXED, __HIP_MEMORY_SCOPE_AGENT
#define LDS_WAIT() asm volatile("s_waitcnt lgkmcnt(0)" ::: "memory")
#define VM_WAIT() asm volatile("s_waitcnt vmcnt(0)" ::: "memory")
__device__ __forceinline__ unsigned long long rt() { return __builtin_amdgcn_s_memrealtime(); }
__device__ __forceinline__ unsigned f2bf(float f) { unsigned u = __builtin_bit_cast(unsigned, f); return (u + 0x7fffu + ((u >> 16) & 1u)) >> 16; }
__device__ __forceinline__ unsigned pk2(float lo, float hi) { return f2bf(lo) | (f2bf(hi) << 16); }

#define XB_TMO      128
#define XB_XCNT(j)  (256  + 64 * (j))
#define XB_XSUB(j)  (1280 + 64 * (j))
#define XB_XGEN(j)  (2304 + 64 * (j))
#define XB_TOP      3328
#define XB_TOPGEN   3392
#define XCD_BAR_WORDS 3456
#define XB_SPIN_CAP (1u << 18)

__device__ __forceinline__ unsigned xb_ld(unsigned* p)              { return __hip_atomic_load(p, __ATOMIC_RELAXED, __HIP_MEMORY_SCOPE_AGENT); }
__device__ __forceinline__ unsigned xb_add(unsigned* p, unsigned v) { return __hip_atomic_fetch_add(p, v, __ATOMIC_RELAXED, __HIP_MEMORY_SCOPE_AGENT); }
__device__ __forceinline__ unsigned xb_xcc_id() { return (unsigned)__builtin_amdgcn_s_getreg((3 << 11) | 20) & 0xFu; }
#define XB_SPIN(cond, bar) do { unsigned _sp = 0; while (cond) { __builtin_amdgcn_s_sleep(1); \
    if ((++_sp & 255u) == 0u) { if (xb_ld(&(bar)[XB_TMO])) break; if (_sp > XB_SPIN_CAP) { atomicAdd(&(bar)[XB_TMO], 1u); break; } } } } while (0)

struct XcdBarrier {
    unsigned* bar; unsigned x;
    volatile LAS unsigned* st;
};

__device__ __forceinline__ XcdBarrier xcd_barrier_post(unsigned* bar, volatile LAS unsigned* st) {
    XcdBarrier b; b.bar = bar; b.x = xb_xcc_id(); b.st = st;
    if (threadIdx.x == 0) (void)xb_add(&bar[XB_XCNT(b.x)], 1u);
    return b;
}
__device__ __forceinline__ void xcd_barrier_complete(unsigned* bar, unsigned x, unsigned& nloc, unsigned& nx) {
    const unsigned G = gridDim.x * gridDim.y * gridDim.z;
    unsigned sum, cnt, mine, sp = 0u;
    for (;;) {
        sum = 0u; cnt = 0u; mine = 0u;
#pragma unroll
        for (unsigned j = 0; j < 16; ++j) { const unsigned c = xb_ld(&bar[XB_XCNT(j)]); sum += c; cnt += (c > 0u) ? 1u : 0u; mine = (j == x) ? c : mine; }
        if (sum == G) break;
        __builtin_amdgcn_s_sleep(1);
        if ((++sp & 255u) == 0u) { if (xb_ld(&bar[XB_TMO])) break; if (sp > XB_SPIN_CAP) { atomicAdd(&bar[XB_TMO], 1u); break; } }
    }
    nloc = mine > 0u ? mine : 1u; nx = cnt > 0u ? cnt : 1u;
}

__device__ __forceinline__ void xcd_barrier(const XcdBarrier& b) {
    asm volatile("s_waitcnt vmcnt(0)" ::: "memory");
    __syncthreads();
    if (threadIdx.x == 0) {
        unsigned* bar = b.bar;
        __builtin_amdgcn_s_waitcnt(0);
        unsigned nloc = b.st[0], nx = b.st[1];
        if (nloc == 0u) { xcd_barrier_complete(bar, b.x, nloc, nx); b.st[0] = nloc; b.st[1] = nx; }
        const unsigned old = xb_add(&bar[XB_XSUB(b.x)], 1u);
        const unsigned gen = old / nloc;
        if (old + 1u == (gen + 1u) * nloc) {
            __builtin_amdgcn_fence(__ATOMIC_RELEASE, "agent");
            asm volatile("s_waitcnt vmcnt(0)" ::: "memory");
            const unsigned og = xb_add(&bar[XB_TOP], 1u);
            const unsigned tg = og / nx;
            if (og + 1u == (tg + 1u) * nx) xb_add(&bar[XB_TOPGEN], 1u);
            else XB_SPIN(xb_ld(&bar[XB_TOPGEN]) == tg, bar);
            __builtin_amdgcn_fence(__ATOMIC_ACQUIRE, "agent");
            xb_add(&bar[XB_XGEN(b.x)], 1u);
            asm volatile("s_waitcnt vmcnt(0)" ::: "memory");
        } else {
            XB_SPIN(xb_ld(&bar[XB_XGEN(b.x)]) == gen, bar);
            __builtin_amdgcn_fence(__ATOMIC_ACQUIRE, "agent");
            asm volatile("s_waitcnt vmcnt(0)" ::: "memory");
        }
    }
    __syncthreads();
}

typedef float f32x16 __attribute__((ext_vector_type(16)));
typedef float f32x2 __attribute__((ext_vector_type(2)));
typedef short s16x4 __attribute__((ext_vector_type(4)));
typedef __bf16 bf16x2_t __attribute__((ext_vector_type(2)));

#define WAVE_DPP_(v, ctrl) __builtin_bit_cast(float, __builtin_amdgcn_update_dpp(0, __builtin_bit_cast(int, v), ctrl, 0xF, 0xF, true))
__device__ __forceinline__ float wave_sum(float v) {
    v += WAVE_DPP_(v, 0xB1); v += WAVE_DPP_(v, 0x4E); v += WAVE_DPP_(v, 0x141); v += WAVE_DPP_(v, 0x140);
    { auto rr = __builtin_amdgcn_permlane16_swap(__float_as_uint(v), __float_as_uint(v), false, false); v = __uint_as_float(rr[0]) + __uint_as_float(rr[1]); }
    { auto rr = __builtin_amdgcn_permlane32_swap(__float_as_uint(v), __float_as_uint(v), false, false); v = __uint_as_float(rr[0]) + __uint_as_float(rr[1]); }
    return v;
}
__device__ __forceinline__ float wave_max(float v) {
    v = fmaxf(v, WAVE_DPP_(v, 0xB1)); v = fmaxf(v, WAVE_DPP_(v, 0x4E)); v = fmaxf(v, WAVE_DPP_(v, 0x141)); v = fmaxf(v, WAVE_DPP_(v, 0x140));
    { auto rr = __builtin_amdgcn_permlane16_swap(__float_as_uint(v), __float_as_uint(v), false, false); v = fmaxf(__uint_as_float(rr[0]), __uint_as_float(rr[1])); }
    { auto rr = __builtin_amdgcn_permlane32_swap(__float_as_uint(v), __float_as_uint(v), false, false); v = fmaxf(__uint_as_float(rr[0]), __uint_as_float(rr[1])); }
    return v;
}
__device__ __forceinline__ float shl_f(float v, int src) { return __int_as_float(__builtin_amdgcn_ds_bpermute(src << 2, __float_as_int(v))); }
__device__ __forceinline__ int shl_i(int v, int src) { return __builtin_amdgcn_ds_bpermute(src << 2, v); }
__device__ __forceinline__ float bf_lo(unsigned u) { return __builtin_bit_cast(float, u << 16); }
__device__ __forceinline__ float bf_hi(unsigned u) { return __builtin_bit_cast(float, u & 0xffff0000u); }
__device__ __forceinline__ unsigned cvtpk(float lo, float hi) { f32x2 v = {lo, hi}; bf16x2_t b = __builtin_convertvector(v, bf16x2_t); return __builtin_bit_cast(unsigned, b); }
__device__ __forceinline__ float fast_exp2(float x) { return __builtin_amdgcn_exp2f(x); }
__device__ __forceinline__ float fast_rcp(float x) { return __builtin_amdgcn_rcpf(x); }
__device__ __forceinline__ float halves_max(float m) { auto rr = __builtin_amdgcn_permlane32_swap(__float_as_uint(m), __float_as_uint(m), false, false); return fmaxf(__uint_as_float(rr[0]), __uint_as_float(rr[1])); }
__device__ __forceinline__ float halves_sum(float m) { auto rr = __builtin_amdgcn_permlane32_swap(__float_as_uint(m), __float_as_uint(m), false, false); return __uint_as_float(rr[0]) + __uint_as_float(rr[1]); }
__device__ __forceinline__ unsigned halves_umax(unsigned m) { auto rr = __builtin_amdgcn_permlane32_swap(m, m, false, false); return rr[0] > rr[1] ? rr[0] : rr[1]; }

__device__ __forceinline__ int rope64_src(int j) { return (j & 1) ? (j >> 1) + 32 : (j >> 1); }
__device__ __forceinline__ int rope32_src(int j) { return (j & 1) ? (j >> 1) + 16 : (j >> 1); }
struct MapId { __device__ __forceinline__ int operator()(int n) const { return n; } };
struct MapIn { __device__ __forceinline__ int operator()(int n) const {
    if (n < 640) return (n & ~63) + rope64_src(n & 63);
    if (n < 768) return n;
    if (n < 1536) { const int m = n - 768; if (m < 640) return 768 + m; if (m < 672) return 1408 + rope32_src(m - 640); return -1; }
    if (n < 2560) { const int m = n - 1536; return 1440 + (m & ~63) + rope64_src(m & 63); }
    return 2464 + (n - 2560);
} };
struct MapQup { __device__ __forceinline__ int operator()(int n) const { if (n < 512) return (n >> 6) * 96 + (n & 63); const int m = n - 512; return (m >> 5) * 96 + 64 + rope32_src(m & 31); } };
struct MapKvup { __device__ __forceinline__ int operator()(int n) const { if (n < 512) return (n >> 6) * 128 + (n & 63); const int m = n - 512; return (m >> 6) * 128 + 64 + (m & 63); } };

template <class Map>
__device__ __forceinline__ void conv_item(const float* __restrict__ W, int ldw, const float* __restrict__ kscale, int K, bf16* WT, int n0, int k0, const Map& map, LAS float* scr, int lane, float f8 = 0.f  ) {
    const int nn = lane & 31; const int src = map(n0 + nn);
    float v[32];
#pragma unroll
    for (int i = 0; i < 32; ++i) { const int kk = 2 * i + (lane >> 5); v[i] = (src >= 0) ? W[(size_t)(k0 + kk) * ldw + src] : 0.f; }
#pragma unroll
    for (int i = 0; i < 32; ++i) { const int kk = 2 * i + (lane >> 5); float x = v[i];
        if (kscale) x *= kscale[k0 + kk];
        scr[kk * 33 + nn] = x; }
    LDS_WAIT(); asm volatile("" ::: "memory");
    const int c = lane & 7;
#pragma unroll
    for (int j = 0; j < 4; ++j) { const int n = (lane >> 3) + 8 * j; const LAS float* s = scr + (8 * c) * 33 + n;
        if (f8 != 0.f) { float y[8];
#pragma unroll
            for (int e = 0; e < 8; ++e) y[e] = __builtin_amdgcn_fmed3f(s[e * 33] * f8, -440.f, 440.f);
            int lo = __builtin_amdgcn_cvt_pk_fp8_f32(y[0], y[1], 0, false); lo = __builtin_amdgcn_cvt_pk_fp8_f32(y[2], y[3], lo, true);
            int hi2 = __builtin_amdgcn_cvt_pk_fp8_f32(y[4], y[5], 0, false); hi2 = __builtin_amdgcn_cvt_pk_fp8_f32(y[6], y[7], hi2, true);
            *(GAS unsigned long long*)((unsigned char*)WT + (size_t)(n0 + n) * K + k0 + 8 * c) = (unsigned long long)(unsigned)lo | ((unsigned long long)(unsigned)hi2 << 32); }
        else { v4u o; o.x = pk2(s[0 * 33], s[1 * 33]); o.y = pk2(s[2 * 33], s[3 * 33]); o.z = pk2(s[4 * 33], s[5 * 33]); o.w = pk2(s[6 * 33], s[7 * 33]);
            *(GAS v4u*)(WT + (size_t)(n0 + n) * K + k0 + 8 * c) = o; } }
    LDS_WAIT(); asm volatile("" ::: "memory");
}

struct Ptrs {
    const float* in[27]; float* out; unsigned char* ws;
};

__device__ __forceinline__ void convert_weights(const Ptrs& P, int l, LAS unsigned char* lds, int gw, int NGW, int wave, int lane) {
    LAS float* scr = (LAS float*)(lds + wave * 16384);
    unsigned char* ws = P.ws;
    constexpr int I_IN = 16 * 144, I_G = 16 * 32, I_B = 8 * 32, I_O = 16 * 32, I_Q = 16 * 64, I_QU = 6 * 24, I_KU = 4 * 32;
    constexpr int NIT = I_IN + 4 * I_G + 4 * I_B + I_O + I_Q + I_QU + I_KU;
    for (int it = gw; it < NIT; it += NGW) {
        int r = it;
        if (r < I_IN) { conv_item(P.in[4] + (size_t)l * 1024 * D_IN, D_IN, nullptr, 1024, (bf16*)(ws + WS_WIN), 32 * (r % 144), 64 * (r / 144), MapIn(), scr, lane, W8_SCALE); continue; } r -= I_IN;
        if (r < 4 * I_G) { const int n = r / I_G, q = r % I_G; conv_item(P.in[16] + ((size_t)l * 4 + n) * 1024 * 1024, 1024, nullptr, 1024, (bf16*)(ws + WS_WG + (size_t)n * 1024 * 1024), 32 * (q % 32), 64 * (q / 32), MapId(), scr, lane, W8_SCALE); continue; } r -= 4 * I_G;
        if (r < 4 * I_B) { const int n = r / I_B, q = r % I_B; conv_item(P.in[17] + ((size_t)l * 4 + n) * 512 * 1024, 1024, nullptr, 512, (bf16*)(ws + WS_WB + (size_t)n * 1024 * 512), 32 * (q % 32), 64 * (q / 32), MapId(), scr, lane, W8_SCALE); continue; } r -= 4 * I_B;
        if (r < I_O) { conv_item(P.in[18] + (size_t)l * 1024 * 1024, 1024, nullptr, 1024, (bf16*)(ws + WS_WO), 32 * (r % 32), 64 * (r / 32), MapId(), scr, lane, W8_SCALE); continue; } r -= I_O;
        if (r < I_Q) { conv_item(P.in[21] + (size_t)l * 1024 * 2048, 2048, nullptr, 1024, (bf16*)(ws + WS_WQ), 32 * (r % 64), 64 * (r / 64), MapId(), scr, lane); continue; } r -= I_Q;
        if (r < I_QU) { conv_item(P.in[7] + (size_t)l * 384 * 768, 768, P.in[6] + l * 384, 384, (bf16*)(ws + WS_QUP), 32 * (r % 24), 64 * (r / 24), MapQup(), scr, lane); continue; } r -= I_QU;
        conv_item(P.in[9] + (size_t)l * 256 * 1024, 1024, P.in[8] + l * 256, 256, (bf16*)(ws + WS_KVUP), 32 * (r % 32), 64 * (r / 32), MapKvup(), scr, lane);
    }
    const float* ks = P.in[22] + (size_t)l * 262144; bf16* kd = (bf16*)(ws + WS_KEYS);
    for (int i = gw * 64 + lane; i < 262144 / 8; i += NGW * 64) {
        const f32x4 a = *(const GAS f32x4*)(ks + 8 * i), b = *(const GAS f32x4*)(ks + 8 * i + 4);
        v4u o; o.x = pk2(a.x, a.y); o.y = pk2(a.z, a.w); o.z = pk2(b.x, b.y); o.w = pk2(b.z, b.w);
        *(GAS v4u*)(kd + 8 * i) = o; }
}

__device__ __forceinline__ void compute_mod(const Ptrs& P, LAS unsigned char* lds, int tid) {
    LAS float* sc = (LAS float*)lds; LAS float* red = (LAS float*)(lds + 16384);
    for (int i = tid; i < 4096; i += NTHR) { const float c = P.in[1][i]; sc[i] = c / (1.f + __expf(-c)); }
    __syncthreads();
    float* mod = (float*)(P.ws + WS_MOD);
    for (int item = blockIdx.x; item < 96; item += gridDim.x) {
        const int l = item / 48, cb = item % 48, cl = tid & 127, kg = tid >> 7, col = cb * 128 + cl;
        const float* w = P.in[2] + ((size_t)l * 1024 + kg * 256) * 6144 + col;
        float a0 = 0.f, a1 = 0.f, a2 = 0.f, a3 = 0.f;
#pragma unroll 16
        for (int k = 0; k < 256; ++k) { const float wv = w[(size_t)k * 6144]; const int kk = kg * 256 + k;
            a0 += sc[kk] * wv; a1 += sc[1024 + kk] * wv; a2 += sc[2048 + kk] * wv; a3 += sc[3072 + kk] * wv; }
        red[(kg * 4 + 0) * 128 + cl] = a0; red[(kg * 4 + 1) * 128 + cl] = a1; red[(kg * 4 + 2) * 128 + cl] = a2; red[(kg * 4 + 3) * 128 + cl] = a3;
        __syncthreads();
        { const int b = tid >> 7; const float s = red[(0 * 4 + b) * 128 + cl] + red[(1 * 4 + b) * 128 + cl] + red[(2 * 4 + b) * 128 + cl] + red[(3 * 4 + b) * 128 + cl];
          mod[((size_t)l * 4 + b) * 6144 + col] = s + P.in[3][l * 6144 + col]; }
        __syncthreads();
    }
}

__device__ __forceinline__ void compute_rope(const Ptrs& P, const float* inv64, const float* inv32, int gtid, int nthr) {
    f32x2* r64 = (f32x2*)(P.ws + WS_ROPE64); f32x2* r32 = (f32x2*)(P.ws + WS_ROPE32);
    for (int i = gtid; i < SEQ * 48; i += nthr) {
        const bool big = i < SEQ * 32; const int j = big ? i : i - SEQ * 32; const int pos = big ? (j >> 5) : (j >> 4); const int f = big ? (j & 31) : (j & 15);
        const float ang = (float)pos * (big ? inv64[f] : inv32[f]);
        double tr = (double)ang * 0.15915494309189535; tr -= rint(tr); const float fr = (float)tr;
        f32x2 cs; cs.x = __builtin_amdgcn_cosf(fr); cs.y = __builtin_amdgcn_sinf(fr);
        if (big) r64[j] = cs; else r32[j] = cs; }
}

__device__ __forceinline__ void load_row(f32x4 (&v)[4], const float* xrow, int lane) {
    const GAS f32x4* xr = (const GAS f32x4*)xrow + lane;
#pragma unroll
    for (int j = 0; j < 4; ++j) v[j] = xr[64 * j];
}
__device__ __forceinline__ void ln_mod_row(f32x4 (&v)[4], const float* sh, const float* sc, unsigned char* orow  , int lane) {
    float s = 0.f;
#pragma unroll
    for (int j = 0; j < 4; ++j) s += (v[j].x + v[j].y) + (v[j].z + v[j].w);
    const float mean = wave_sum(s) * (1.f / DM); float s2 = 0.f;
#pragma unroll
    for (int j = 0; j < 4; ++j) { v[j] = v[j] - mean; s2 += (v[j].x * v[j].x + v[j].y * v[j].y) + (v[j].z * v[j].z + v[j].w * v[j].w); }
    const float rstd = 1.f / sqrtf(wave_sum(s2) * (1.f / DM) + LN_EPS);
    GAS int* o4 = (GAS int*)orow + lane;
#pragma unroll
    for (int j = 0; j < 4; ++j) { const f32x4 a = ((const GAS f32x4*)sc)[lane + 64 * j], b = ((const GAS f32x4*)sh)[lane + 64 * j];
        f32x4 y = (v[j] * rstd * (a + 1.f) + b) * U8_SCALE; y.x = __builtin_amdgcn_fmed3f(y.x, -440.f, 440.f); y.y = __builtin_amdgcn_fmed3f(y.y, -440.f, 440.f); y.z = __builtin_amdgcn_fmed3f(y.z, -440.f, 440.f); y.w = __builtin_amdgcn_fmed3f(y.w, -440.f, 440.f);
        int wd = __builtin_amdgcn_cvt_pk_fp8_f32(y.x, y.y, 0, false); wd = __builtin_amdgcn_cvt_pk_fp8_f32(y.z, y.w, wd, true); o4[64 * j] = wd; }
}

#define EPI_ROWS_BEGIN \
    _Pragma("unroll") for (int ai = 0; ai < 2; ++ai) _Pragma("unroll") for (int m = 0; m < 4; ++m) { const int row = u.pm * 256 + ai * 128 + wr * 64 + m * 16 + fr;
#define EPI_ROWS_END }
__device__ __forceinline__ void store8(bf16* p, const float (&x)[8]) { v4u w; w.x = cvtpk(x[0], x[1]); w.y = cvtpk(x[2], x[3]); w.z = cvtpk(x[4], x[5]); w.w = cvtpk(x[6], x[7]); *(GAS v4u*)p = w; }
__device__ __forceinline__ void rope4(float (&x)[8], const f32x2* tab) {
    const f32x4 t0 = *(const GAS f32x4*)tab, t1 = *(const GAS f32x4*)(tab + 2);
    const float c[4] = {t0.x, t0.z, t1.x, t1.z}, s[4] = {t0.y, t0.w, t1.y, t1.w};
#pragma unroll
    for (int k = 0; k < 4; ++k) { const float a = x[2 * k], b = x[2 * k + 1]; x[2 * k] = a * c[k] - b * s[k]; x[2 * k + 1] = a * s[k] + b * c[k]; }
}

struct EpiInProj {
    unsigned char* ws;
    __device__ __forceinline__ void operator()(const pg8::f32x4 (&acc)[2][2][4][2], const pg8::Unit& u, int wr, int wc, int fr, int fq) {
        const int pn = u.pn; size_t boff; int pitch, lc0, mode0, mode1;
        if (pn < 2) { boff = WS_SWAQ; pitch = 512; lc0 = pn * 256; mode0 = mode1 = 2; }
        else if (pn == 2) { boff = WS_SWAKV; pitch = 256; lc0 = 0; mode0 = 1; mode1 = 0; }
        else if (pn < 6) { boff = WS_LAT; pitch = 768; lc0 = (pn - 3) * 256; mode0 = 0; mode1 = (pn == 5) ? 4 : 0; }
        else { const int q = (pn - 6) >> 1; boff = WS_DIFQ + (size_t)q * 32 * MiB; pitch = 512; lc0 = ((pn - 6) & 1) * 256; mode0 = mode1 = (q == 0) ? 2 : (q == 1) ? 1 : (q == 3) ? 3 : 0; }
        bf16* base = (bf16*)(ws + boff);
        const f32x2* r64 = (const f32x2*)(ws + WS_ROPE64); const f32x2* r32 = (const f32x2*)(ws + WS_ROPE32);
        if (pn >= 10 && pn < 12) {
#pragma unroll
            for (int ai = 0; ai < 2; ++ai) { const int row0 = u.pm * 256 + ai * 128 + wr * 64; const int bb = row0 >> 13, s0 = row0 & (SEQ - 1);
#pragma unroll
                for (int bj = 0; bj < 2; ++bj) { const int col = (pn - 10) * 256 + bj * 128 + wc * 32 + fq * 8;
#pragma unroll
                    for (int k = 0; k < 8; ++k) {
                        int wd = __builtin_amdgcn_cvt_pk_fp8_f32(acc[ai][bj][0][k >> 2][k & 3] * UW8_INV, acc[ai][bj][1][k >> 2][k & 3] * UW8_INV, 0, false);
                        wd = __builtin_amdgcn_cvt_pk_fp8_f32(acc[ai][bj][2][k >> 2][k & 3] * UW8_INV, acc[ai][bj][3][k >> 2][k & 3] * UW8_INV, wd, true);
                        *(GAS int*)(ws + WS_DIFV + ((size_t)(bb * 512 + col + k) << 13) + s0 + 4 * fr) = wd; } } }
            return; }
        EPI_ROWS_BEGIN
            const int pos = row & (SEQ - 1);
#pragma unroll
            for (int bj = 0; bj < 2; ++bj) {
                const int mode = bj ? mode1 : mode0; const int lcol = lc0 + bj * 128 + wc * 32 + fq * 8;
                float x[8] = {acc[ai][bj][m][0][0], acc[ai][bj][m][0][1], acc[ai][bj][m][0][2], acc[ai][bj][m][0][3], acc[ai][bj][m][1][0], acc[ai][bj][m][1][1], acc[ai][bj][m][1][2], acc[ai][bj][m][1][3]};
#pragma unroll
                for (int k = 0; k < 8; ++k) x[k] *= UW8_INV;
                if (mode == 1 || mode == 2) rope4(x, r64 + pos * 32 + ((lcol & 63) >> 1));
                if (mode == 4 && lcol >= 640 && lcol < 672) rope4(x, r32 + pos * 16 + ((lcol - 640) >> 1));
                if (mode == 2 || mode == 3) {
#pragma unroll
                    for (int k = 0; k < 8; ++k) x[k] *= C_D64; }
                if (pn >= 8 && pn < 10) {
                    int lo = __builtin_amdgcn_cvt_pk_fp8_f32(x[0], x[1], 0, false); lo = __builtin_amdgcn_cvt_pk_fp8_f32(x[2], x[3], lo, true);
                    int hi2 = __builtin_amdgcn_cvt_pk_fp8_f32(x[4], x[5], 0, false); hi2 = __builtin_amdgcn_cvt_pk_fp8_f32(x[6], x[7], hi2, true);
                    *(GAS unsigned long long*)(ws + WS_DIFK + (size_t)row * 512 + lcol) = (unsigned long long)(unsigned)lo | ((unsigned long long)(unsigned)hi2 << 32); }
                else store8(base + (size_t)row * pitch + lcol, x);
            }
        EPI_ROWS_END
    }
};
struct EpiQup {
    unsigned char* ws;
    __device__ __forceinline__ void operator()(const pg8::f32x4 (&acc)[2][2][4][2], const pg8::Unit& u, int wr, int wc, int fr, int fq) {
        const int pn = u.pn; const float* rstd = (const float*)(ws + WS_RSTD);
        bf16* base = (bf16*)(ws + (pn < 2 ? WS_MQN : WS_MQR)); const int pitch = pn < 2 ? 512 : 256, lc0 = pn < 2 ? pn * 256 : 0;
        EPI_ROWS_BEGIN
            const float sc = rstd[2 * row] * C_MLA;
#pragma unroll
            for (int bj = 0; bj < 2; ++bj) {
                const int lcol = lc0 + bj * 128 + wc * 32 + fq * 8;
                float x[8] = {acc[ai][bj][m][0][0], acc[ai][bj][m][0][1], acc[ai][bj][m][0][2], acc[ai][bj][m][0][3], acc[ai][bj][m][1][0], acc[ai][bj][m][1][1], acc[ai][bj][m][1][2], acc[ai][bj][m][1][3]};
#pragma unroll
                for (int k = 0; k < 8; ++k) x[k] *= sc;
                store8(base + (size_t)row * pitch + lcol, x);
            }
        EPI_ROWS_END
    }
};
struct EpiScaleRow {
    bf16* O; int ldc; const float* rowscale; int rs_stride; int k8cols = 0;
    unsigned char* vt = nullptr;
    __device__ __forceinline__ void operator()(const pg8::f32x4 (&acc)[2][2][4][2], const pg8::Unit& u, int wr, int wc, int fr, int fq) {
        if (vt != nullptr && u.pn >= 2) {
#pragma unroll
            for (int ai = 0; ai < 2; ++ai) { const int row0 = u.pm * 256 + ai * 128 + wr * 64; const int bb = row0 >> 13, s0 = row0 & (SEQ - 1);
                const float s0_ = rowscale[(size_t)(row0 + fr) * rs_stride], s1_ = rowscale[(size_t)(row0 + 16 + fr) * rs_stride], s2_ = rowscale[(size_t)(row0 + 32 + fr) * rs_stride], s3_ = rowscale[(size_t)(row0 + 48 + fr) * rs_stride];
#pragma unroll
                for (int bj = 0; bj < 2; ++bj) { const int col = (u.pn - 2) * 256 + bj * 128 + wc * 32 + fq * 8;
#pragma unroll
                    for (int k = 0; k < 8; ++k) {
                        int wd = __builtin_amdgcn_cvt_pk_fp8_f32(acc[ai][bj][0][k >> 2][k & 3] * s0_, acc[ai][bj][1][k >> 2][k & 3] * s1_, 0, false);
                        wd = __builtin_amdgcn_cvt_pk_fp8_f32(acc[ai][bj][2][k >> 2][k & 3] * s2_, acc[ai][bj][3][k >> 2][k & 3] * s3_, wd, true);
                        *(GAS int*)(vt + ((size_t)(bb * 512 + col + k) << 13) + s0 + 4 * fr) = wd; } } }
            return; }
        EPI_ROWS_BEGIN
            const float sc = rowscale ? rowscale[(size_t)row * rs_stride] : 1.f;
#pragma unroll
            for (int bj = 0; bj < 2; ++bj) {
                const int col = u.pn * 256 + bj * 128 + wc * 32 + fq * 8;
                float x[8] = {acc[ai][bj][m][0][0], acc[ai][bj][m][0][1], acc[ai][bj][m][0][2], acc[ai][bj][m][0][3], acc[ai][bj][m][1][0], acc[ai][bj][m][1][1], acc[ai][bj][m][1][2], acc[ai][bj][m][1][3]};
#pragma unroll
                for (int k = 0; k < 8; ++k) x[k] *= sc;
                if (col < k8cols) { int lo = __builtin_amdgcn_cvt_pk_fp8_f32(x[0], x[1], 0, false); lo = __builtin_amdgcn_cvt_pk_fp8_f32(x[2], x[3], lo, true);
                    int hi2 = __builtin_amdgcn_cvt_pk_fp8_f32(x[4], x[5], 0, false); hi2 = __builtin_amdgcn_cvt_pk_fp8_f32(x[6], x[7], hi2, true);
                    *(GAS unsigned long long*)((unsigned char*)(O + (size_t)row * ldc) + col) = (unsigned long long)(unsigned)lo | ((unsigned long long)(unsigned)hi2 << 32); }
                else store8(O + (size_t)row * ldc + col, x);
            }
        EPI_ROWS_END
    }
};
struct EpiSigmoid {
    unsigned char* O;
    __device__ __forceinline__ void operator()(const pg8::f32x4 (&acc)[2][2][4][2], const pg8::Unit& u, int wr, int wc, int fr, int fq) {
        EPI_ROWS_BEGIN
#pragma unroll
            for (int bj = 0; bj < 2; ++bj) {
                const int col = u.pn * 256 + bj * 128 + wc * 32 + fq * 8;
                float x[8] = {acc[ai][bj][m][0][0], acc[ai][bj][m][0][1], acc[ai][bj][m][0][2], acc[ai][bj][m][0][3], acc[ai][bj][m][1][0], acc[ai][bj][m][1][1], acc[ai][bj][m][1][2], acc[ai][bj][m][1][3]};
#pragma unroll
                for (int k = 0; k < 8; ++k) x[k] = fast_rcp(1.f + fast_exp2((-LOG2E * UW8_INV) * x[k]));
                int lo = __builtin_amdgcn_cvt_pk_fp8_f32(x[0], x[1], 0, false); lo = __builtin_amdgcn_cvt_pk_fp8_f32(x[2], x[3], lo, true);
                int hi2 = __builtin_amdgcn_cvt_pk_fp8_f32(x[4], x[5], 0, false); hi2 = __builtin_amdgcn_cvt_pk_fp8_f32(x[6], x[7], hi2, true);
                *(GAS unsigned long long*)(O + (size_t)row * 1024 + col) = (unsigned long long)(unsigned)lo | ((unsigned long long)(unsigned)hi2 << 32);
            }
        EPI_ROWS_END
    }
};
struct EpiGated {
    const unsigned char* G; unsigned char* Pp; unsigned char* Mg8; int n;
    __device__ __forceinline__ void operator()(const pg8::f32x4 (&acc)[2][2][4][2], const pg8::Unit& u, int wr, int wc, int fr, int fq) {
        EPI_ROWS_BEGIN
#pragma unroll
            for (int bj = 0; bj < 2; ++bj) {
                const int col = u.pn * 256 + bj * 128 + wc * 32 + fq * 8; const size_t off = (size_t)row * 1024 + col;
                float x[8] = {acc[ai][bj][m][0][0], acc[ai][bj][m][0][1], acc[ai][bj][m][0][2], acc[ai][bj][m][0][3], acc[ai][bj][m][1][0], acc[ai][bj][m][1][1], acc[ai][bj][m][1][2], acc[ai][bj][m][1][3]};
#pragma unroll
                for (int k = 0; k < 8; ++k) x[k] *= 1.f / (O8_SCALE * W8_SCALE);
                { const unsigned long long g = *(const GAS unsigned long long*)(G + off); const int g0 = (int)(unsigned)g, g1 = (int)(unsigned)(g >> 32);
                  const f32x2 a = __builtin_amdgcn_cvt_pk_f32_fp8(g0, false), b = __builtin_amdgcn_cvt_pk_f32_fp8(g0, true), c = __builtin_amdgcn_cvt_pk_f32_fp8(g1, false), d = __builtin_amdgcn_cvt_pk_f32_fp8(g1, true);
                  x[0] *= a.x; x[1] *= a.y; x[2] *= b.x; x[3] *= b.y; x[4] *= c.x; x[5] *= c.y; x[6] *= d.x; x[7] *= d.y; }
                if (n > 0) { const unsigned long long o = *(const GAS unsigned long long*)(Pp + off); const int o0 = (int)(unsigned)o, o1 = (int)(unsigned)(o >> 32);
                  const f32x2 a = __builtin_amdgcn_cvt_pk_f32_fp8(o0, false), b = __builtin_amdgcn_cvt_pk_f32_fp8(o0, true), c = __builtin_amdgcn_cvt_pk_f32_fp8(o1, false), d = __builtin_amdgcn_cvt_pk_f32_fp8(o1, true);
                  x[0] += a.x * (1.f / 64.f); x[1] += a.y * (1.f / 64.f); x[2] += b.x * (1.f / 64.f); x[3] += b.y * (1.f / 64.f); x[4] += c.x * (1.f / 64.f); x[5] += c.y * (1.f / 64.f); x[6] += d.x * (1.f / 64.f); x[7] += d.y * (1.f / 64.f); }
                { float y[8]; unsigned char* dst_ = (n < 3) ? Pp : Mg8;
#pragma unroll
                    for (int k = 0; k < 8; ++k) y[k] = __builtin_amdgcn_fmed3f(x[k] * 64.f, -440.f, 440.f);
                    int lo = __builtin_amdgcn_cvt_pk_fp8_f32(y[0], y[1], 0, false); lo = __builtin_amdgcn_cvt_pk_fp8_f32(y[2], y[3], lo, true);
                    int hi2 = __builtin_amdgcn_cvt_pk_fp8_f32(y[4], y[5], 0, false); hi2 = __builtin_amdgcn_cvt_pk_fp8_f32(y[6], y[7], hi2, true);
                    *(GAS unsigned long long*)(dst_ + off) = (unsigned long long)(unsigned)lo | ((unsigned long long)(unsigned)hi2 << 32); }
            }
        EPI_ROWS_END
    }
};
struct EpiResid {
    const float* X; float* Z; const float* gate;
    __device__ __forceinline__ void operator()(const pg8::f32x4 (&acc)[2][2][4][2], const pg8::Unit& u, int wr, int wc, int fr, int fq) {
        EPI_ROWS_BEGIN
            const float* gb = gate + (size_t)(row / SEQ) * 6144;
#pragma unroll
            for (int bj = 0; bj < 2; ++bj) {
                const int col = u.pn * 256 + bj * 128 + wc * 32 + fq * 8; const size_t off = (size_t)row * 1024 + col;
#pragma unroll
                for (int n = 0; n < 2; ++n) { const f32x4 xv = *(const GAS f32x4*)(X + off + 4 * n), gv = *(const GAS f32x4*)(gb + col + 4 * n);
                    f32x4 a; a.x = acc[ai][bj][m][n][0]; a.y = acc[ai][bj][m][n][1]; a.z = acc[ai][bj][m][n][2]; a.w = acc[ai][bj][m][n][3];
                    *(GAS f32x4*)(Z + off + 4 * n) = xv * DN_ALPHA + gv * (a * (1.f / (64.f * W8_SCALE))); }
            }
        EPI_ROWS_END
    }
};

__device__ __forceinline__ float max3f(float a, float b, float c) { float r; asm("v_max3_f32 %0, %1, %2, %3" : "=v"(r) : "v"(a), "v"(b), "v"(c)); return r; }
__device__ __forceinline__ float max2f(float a, float b) { float r; asm("v_max_f32_e32 %0, %1, %2" : "=v"(r) : "v"(a), "v"(b)); return r; }
__device__ __forceinline__ float fadd_s(float a, float b) { float r; asm("v_add_f32_e32 %0, %1, %2" : "=v"(r) : "v"(a), "v"(b)); return r; }
__device__ __forceinline__ float fsub_s(float a, float b) { float r; asm("v_sub_f32_e32 %0, %1, %2" : "=v"(r) : "v"(a), "v"(b)); return r; }
__device__ __forceinline__ int crow(int r, int hi) { return (r & 3) + 8 * (r >> 2) + 4 * hi; }
__device__ __forceinline__ s16x4 vtr(const LAS unsigned char* p) { typedef short v4i16_t __attribute__((ext_vector_type(4))); return __builtin_bit_cast(s16x4, __builtin_amdgcn_ds_read_tr16_b64_v4i16((LAS v4i16_t*)p)); }

__device__ __forceinline__ void dma16(const void* g, LAS unsigned char* l) {
    const unsigned dst = (unsigned)__builtin_amdgcn_readfirstlane((int)(unsigned)(size_t)l); unsigned keep;
    asm volatile("s_mov_b32 %0, m0\n\ts_mov_b32 m0, %2\n\ts_nop 0\n\tglobal_load_lds_dwordx4 %1, off\n\ts_mov_b32 m0, %0" : "=&s"(keep) : "v"(g), "s"(dst) : "memory");
}
template <int N> __device__ __forceinline__ void wait_vm() { if constexpr (N == 0) asm volatile("s_waitcnt vmcnt(0)" ::: "memory"); else if constexpr (N == 1) asm volatile("s_waitcnt vmcnt(1)" ::: "memory"); else if constexpr (N == 2) asm volatile("s_waitcnt vmcnt(2)" ::: "memory");
    else if constexpr (N == 3) asm volatile("s_waitcnt vmcnt(3)" ::: "memory"); else if constexpr (N == 4) asm volatile("s_waitcnt vmcnt(4)" ::: "memory"); else asm volatile("s_waitcnt vmcnt(6)" ::: "memory"); }
#define FL_BAR() do { asm volatile("s_waitcnt lgkmcnt(0)" ::: "memory"); __builtin_amdgcn_s_barrier(); asm volatile("" ::: "memory"); } while (0)
typedef int i32x4_t __attribute__((ext_vector_type(4)));
typedef int i32x8_t __attribute__((ext_vector_type(8)));
template <class P, int VAR = 0, bool FIX = false>
__device__ __forceinline__ void flash_run(const P& pol, LAS unsigned char* lds, const bf16x8 (&qf)[P::DQK / 16], f32x16 (&o)[P::DV / 32], float& m_io, float& l_io) {
    constexpr int DQK = P::DQK, DV = P::DV, NDB = DV / 32, PPW = P::PPW, STAGE = P::STAGE, VOFF = P::VOFF;
    constexpr bool LSUM = FIX && P::LSUM;
    constexpr bool NEGM = P::NEGM && !FIX;
    int tid = threadIdx.x; asm volatile("" : "+v"(tid)); const int lane = tid & 63, r32 = lane & 31, hi = lane >> 5; const int wave = __builtin_amdgcn_readfirstlane(tid >> 6);
    const int nt = pol.ntiles;
    const int koff0 = r32 * 128 + 16 * (hi ^ ((r32 >> 1) & 7));
#define FL_DMA(t) pol.dma((t), lds + ((t) & 3) * STAGE, wave, lane)
#define FL_QK(S0, S1, st) do { const LAS unsigned char* kb_ = lds + (st) * STAGE; \
      if constexpr (P::KF8) {        \
        const int ko8_ = r32 * 64 + 16 * ((2 * hi) ^ ((r32 >> 2) & 3)); \
        const i32x4_t q0_ = __builtin_bit_cast(i32x4_t, qf[0]), q1_ = __builtin_bit_cast(i32x4_t, qf[1]); const i32x8_t qq_ = {q0_.x, q0_.y, q0_.z, q0_.w, q1_.x, q1_.y, q1_.z, q1_.w}; \
        const i32x4_t a0_ = *(const LAS i32x4_t*)(kb_ + ko8_), a1_ = *(const LAS i32x4_t*)(kb_ + (ko8_ ^ 16)), b0_ = *(const LAS i32x4_t*)(kb_ + 2048 + ko8_), b1_ = *(const LAS i32x4_t*)(kb_ + 2048 + (ko8_ ^ 16)); \
        const i32x8_t ka8_ = {a0_.x, a0_.y, a0_.z, a0_.w, a1_.x, a1_.y, a1_.z, a1_.w}, kb8_ = {b0_.x, b0_.y, b0_.z, b0_.w, b1_.x, b1_.y, b1_.z, b1_.w}; \
        if constexpr (P::VF8) {        \
        asm volatile("v_mfma_scale_f32_32x32x64_f8f6f4 %0, %1, %2, -2.0, %3, %3 op_sel_hi:[0,0,0]" : "=&v"(S0) : "v"(ka8_), "v"(qq_), "v"(0x7F7F7F7F)); \
        asm volatile("v_mfma_scale_f32_32x32x64_f8f6f4 %0, %1, %2, -2.0, %3, %3 op_sel_hi:[0,0,0]" : "=&v"(S1) : "v"(kb8_), "v"(qq_), "v"(0x7F7F7F7F)); \
        } else { \
        asm volatile("v_mfma_scale_f32_32x32x64_f8f6f4 %0, %1, %2, 0, %3, %3 op_sel_hi:[0,0,0]" : "=&v"(S0) : "v"(ka8_), "v"(qq_), "v"(0x7F7F7F7F)); \
        asm volatile("v_mfma_scale_f32_32x32x64_f8f6f4 %0, %1, %2, 0, %3, %3 op_sel_hi:[0,0,0]" : "=&v"(S1) : "v"(kb8_), "v"(qq_), "v"(0x7F7F7F7F)); } \
        if constexpr (DQK > 64) {        \
            bf16x8 kr_[4]; \
            _Pragma("unroll") for (int s_ = 0; s_ < 2; ++s_) { kr_[s_] = *(const LAS bf16x8*)(kb_ + 8192 + (koff0 ^ (32 * s_))); kr_[2 + s_] = *(const LAS bf16x8*)(kb_ + 8192 + 4096 + (koff0 ^ (32 * s_))); } \
            asm volatile("s_nop 7\n\ts_nop 7\n\ts_nop 7" ::: "memory"); \
            _Pragma("unroll") for (int s_ = 0; s_ < 2; ++s_) S0 = __builtin_amdgcn_mfma_f32_32x32x16_bf16(kr_[s_], qf[4 + s_], S0, 0, 0, 0); \
            _Pragma("unroll") for (int s_ = 0; s_ < 2; ++s_) S1 = __builtin_amdgcn_mfma_f32_32x32x16_bf16(kr_[2 + s_], qf[4 + s_], S1, 0, 0, 0); } \
      } else { \
        bf16x8 ka_[DQK / 16]; \
        _Pragma("unroll") for (int s_ = 0; s_ < DQK / 16; ++s_) { if constexpr (VAR == 7 || VAR == 9) ka_[s_] = qf[s_]; else ka_[s_] = *(const LAS bf16x8*)(kb_ + (s_ < 4 ? 0 : 8192) + (koff0 ^ (32 * (s_ & 3)))); } \
        __builtin_amdgcn_sched_barrier(0); \
        _Pragma("unroll") for (int s_ = 0; s_ < DQK / 16; ++s_) S0 = __builtin_amdgcn_mfma_f32_32x32x16_bf16(ka_[s_], qf[s_], (s_ == 0) ? cinit : S0, 0, 0, 0); \
        __builtin_amdgcn_sched_barrier(0); \
        _Pragma("unroll") for (int s_ = 0; s_ < DQK / 16; ++s_) { if constexpr (VAR == 7 || VAR == 9) ka_[s_] = qf[(s_ + 1) % (DQK / 16)]; else ka_[s_] = *(const LAS bf16x8*)(kb_ + (s_ < 4 ? 0 : 8192) + 4096 + (koff0 ^ (32 * (s_ & 3)))); } \
        __builtin_amdgcn_sched_barrier(0); \
        _Pragma("unroll") for (int s_ = 0; s_ < DQK / 16; ++s_) S1 = __builtin_amdgcn_mfma_f32_32x32x16_bf16(ka_[s_], qf[s_], (s_ == 0) ? cinit : S1, 0, 0, 0); } } while (0)
    if constexpr (VAR != 10) { FL_DMA(0); FL_DMA(1); FL_DMA(2); }
    float ref = 0.f, mrel = m_io, lrun = l_io;
    f32x16 cinit;
#pragma unroll
    for (int r = 0; r < 16; ++r) cinit[r] = 0.f;
    f32x16 sa0, sa1, sb0, sb1;
    constexpr bool MSUM = FIX && P::VF8 && P::MSUM_OK;
    f32x16 msum_; const int sel1_ = (r32 == 0) ? 0x38383838 : 0;
    const i32x8_t selA_ = {sel1_, sel1_, sel1_, sel1_, sel1_, sel1_, sel1_, sel1_};
#pragma unroll
    for (int r = 0; r < 16; ++r) msum_[r] = 0.f;
    f32x16 ol; const bf16x8 ones8 = {16256, 16256, 16256, 16256, 16256, 16256, 16256, 16256};
#pragma unroll
    for (int r = 0; r < 16; ++r) ol[r] = 0.f;
#pragma unroll
    for (int r = 0; r < 16; ++r) { sa0[r] = 0.f; sa1[r] = 0.f; sb0[r] = 0.f; sb1[r] = 0.f; }
    bool act_cur = pol.active(0), act_next = false;
    if (P::HL && wave >= 4) wait_vm<2 * (PPW - 1)>(); else wait_vm<2 * PPW>();
    FL_BAR();
    if (act_cur && VAR != 2 && VAR != 5 && VAR != 10) { FL_QK(sa0, sa1, 0); pol.mask(0, sa0, sa1); }
#define FL_STEP(C0, C1, N0, N1, t) do { const int t_ = (t); \
        if (t_ + 2 < nt) { if (P::HL && wave >= 4) wait_vm<PPW - 1>(); else wait_vm<PPW>(); } else wait_vm<0>(); \
        if constexpr (VAR != 4) FL_BAR();                \
        if (t_ + 3 < nt && VAR != 10) FL_DMA(t_ + 3); \
        act_next = (t_ + 1 < nt) && pol.active(t_ + 1); \
        __builtin_amdgcn_sched_barrier(0); \
        if constexpr (FIX && P::VF8 && P::MSUM_OK && VAR == 0) {        \
            const LAS unsigned char* kb_ = lds + ((t_ + 1) & 3) * STAGE; \
            const int ko8_ = r32 * 64 + 16 * ((2 * hi) ^ ((r32 >> 2) & 3)); \
            const i32x4_t q0_ = __builtin_bit_cast(i32x4_t, qf[0]), q1_ = __builtin_bit_cast(i32x4_t, qf[1]); const i32x8_t qq_ = {q0_.x, q0_.y, q0_.z, q0_.w, q1_.x, q1_.y, q1_.z, q1_.w}; \
            i32x8_t kb8_; bf16x8 kr_[4];        \
            if (act_next) { \
                const i32x4_t a0_ = *(const LAS i32x4_t*)(kb_ + ko8_), a1_ = *(const LAS i32x4_t*)(kb_ + (ko8_ ^ 16)), b0_ = *(const LAS i32x4_t*)(kb_ + 2048 + ko8_), b1_ = *(const LAS i32x4_t*)(kb_ + 2048 + (ko8_ ^ 16)); \
                const i32x8_t ka8_ = {a0_.x, a0_.y, a0_.z, a0_.w, a1_.x, a1_.y, a1_.z, a1_.w}; kb8_ = (i32x8_t){b0_.x, b0_.y, b0_.z, b0_.w, b1_.x, b1_.y, b1_.z, b1_.w}; \
                if constexpr (DQK > 64) { _Pragma("unroll") for (int s_ = 0; s_ < 2; ++s_) { kr_[s_] = *(const LAS bf16x8*)(kb_ + 8192 + (koff0 ^ (32 * s_))); kr_[2 + s_] = *(const LAS bf16x8*)(kb_ + 8192 + 4096 + (koff0 ^ (32 * s_))); } } \
                asm volatile("v_mfma_scale_f32_32x32x64_f8f6f4 %0, %1, %2, -2.0, %3, %3 op_sel_hi:[0,0,0]" : "=&v"(N0) : "v"(ka8_), "v"(qq_), "v"(0x7F7F7F7F)); } \
            __builtin_amdgcn_sched_barrier(0); \
            _Pragma("unroll") for (int r = 0; r < 16; ++r) { C0[r] = fast_exp2(C0[r]); } \
            __builtin_amdgcn_sched_barrier(0); \
            if (act_next) asm volatile("v_mfma_scale_f32_32x32x64_f8f6f4 %0, %1, %2, -2.0, %3, %3 op_sel_hi:[0,0,0]" : "=&v"(N1) : "v"(kb8_), "v"(qq_), "v"(0x7F7F7F7F)); \
            __builtin_amdgcn_sched_barrier(0); \
            _Pragma("unroll") for (int r = 0; r < 16; ++r) { C1[r] = fast_exp2(C1[r]); } \
            __builtin_amdgcn_sched_barrier(0); \
            if constexpr (DQK > 64) { if (act_next) {        \
                asm volatile("s_nop 7\n\ts_nop 7" ::: "memory"); \
                _Pragma("unroll") for (int s_ = 0; s_ < 2; ++s_) N0 = __builtin_amdgcn_mfma_f32_32x32x16_bf16(kr_[s_], qf[4 + s_], N0, 0, 0, 0); \
                _Pragma("unroll") for (int s_ = 0; s_ < 2; ++s_) N1 = __builtin_amdgcn_mfma_f32_32x32x16_bf16(kr_[2 + s_], qf[4 + s_], N1, 0, 0, 0); } } \
            __builtin_amdgcn_sched_barrier(0); \
            { const LAS unsigned char* vb8_ = lds + (t_ & 3) * STAGE + VOFF + r32 * 64 + 16 * ((2 * hi) ^ ((r32 >> 2) & 3)); \
              int pw_[8]; \
              _Pragma("unroll") for (int j = 0; j < 4; ++j) { \
                int u0_, u1_; asm volatile("" : "=v"(u0_), "=v"(u1_)); \
                int w0_ = __builtin_amdgcn_cvt_pk_bf8_f32(C0[4 * j], C0[4 * j + 1], u0_, false); w0_ = __builtin_amdgcn_cvt_pk_bf8_f32(C0[4 * j + 2], C0[4 * j + 3], w0_, true); \
                int w1_ = __builtin_amdgcn_cvt_pk_bf8_f32(C1[4 * j], C1[4 * j + 1], u1_, false); w1_ = __builtin_amdgcn_cvt_pk_bf8_f32(C1[4 * j + 2], C1[4 * j + 3], w1_, true); \
                pw_[j] = w0_; pw_[4 + j] = w1_; } \
              const i32x8_t pp_ = {pw_[0], pw_[1], pw_[2], pw_[3], pw_[4], pw_[5], pw_[6], pw_[7]}; \
              asm volatile("s_nop 1\n\tv_mfma_scale_f32_32x32x64_f8f6f4 %0, %1, %2, %0, %3, %3 op_sel_hi:[0,0,0] blgp:1" : "+v"(msum_) : "v"(selA_), "v"(pp_), "v"(0x7F7F7F7F)); \
              _Pragma("unroll") for (int db = 0; db < NDB; ++db) { \
                const i32x4_t v0_ = *(const LAS i32x4_t*)(vb8_ + db * 2048), v1_ = *(const LAS i32x4_t*)((const LAS unsigned char*)((unsigned)(size_t)vb8_ ^ 16u) + db * 2048); \
                const i32x8_t va_ = {v0_.x, v0_.y, v0_.z, v0_.w, v1_.x, v1_.y, v1_.z, v1_.w}; \
                asm volatile("s_nop 1\n\tv_mfma_scale_f32_32x32x64_f8f6f4 %0, %1, %2, %0, %3, %3 op_sel_hi:[0,0,0] blgp:1" : "+v"(o[db]) : "v"(va_), "v"(pp_), "v"(0x7F7F7F7F)); } } \
        } else { \
        if (act_next && VAR != 2 && VAR != 5 && VAR != 10) { FL_QK(N0, N1, (t_ + 1) & 3); } \
        __builtin_amdgcn_sched_barrier(0); \
        if (act_cur && VAR != 5 && VAR != 10) { \
          if constexpr (!FIX) { \
            float mx = max3f(C0[0], C0[1], C1[0]), mx2 = max3f(C0[2], C0[3], C1[1]); \
            _Pragma("unroll") for (int r = 4; r < 16; r += 2) { mx = max3f(mx, C0[r], C0[r + 1]); } \
            _Pragma("unroll") for (int r = 2; r < 16; r += 2) { mx2 = max3f(mx2, C1[r], C1[r + 1]); } \
            mx = halves_max(max2f(mx, mx2)); \
            const bool changed = mx > mrel; \
            if (__any(changed)) { \
                const float alpha = changed ? fast_exp2(mrel - mx) : 1.f; \
                lrun *= alpha; \
                _Pragma("unroll") for (int db = 0; db < NDB; ++db) _Pragma("unroll") for (int r = 0; r < 16; ++r) o[db][r] *= alpha; \
                if constexpr (NEGM) { const float delta = changed ? mx : 0.f; \
                    _Pragma("unroll") for (int r = 0; r < 16; ++r) { C0[r] -= delta; C1[r] -= delta; } \
                    if (act_next) { _Pragma("unroll") for (int r = 0; r < 16; ++r) { N0[r] -= delta; N1[r] -= delta; } } \
                    ref += delta; mrel = changed ? 0.f : mrel; \
                    _Pragma("unroll") for (int r = 0; r < 16; ++r) cinit[r] = -ref; \
                } else { mrel = changed ? mx : mrel; } \
            } \
          } \
          if constexpr (P::VF8) {        \
            const LAS unsigned char* vb8_ = lds + (t_ & 3) * STAGE + VOFF + r32 * 64 + 16 * ((2 * hi) ^ ((r32 >> 2) & 3)); \
            float rs = 0.f, rs2 = 0.f; \
            if constexpr (FIX) { _Pragma("unroll") for (int r = 0; r < 16; ++r) { C0[r] = fast_exp2(C0[r]); C1[r] = fast_exp2(C1[r]); } } \
            else { _Pragma("unroll") for (int r = 0; r < 16; ++r) { C0[r] = fast_exp2(C0[r] - mrel); C1[r] = fast_exp2(C1[r] - mrel); } } \
            if constexpr (!MSUM) { float ra_ = C0[0];        \
              _Pragma("unroll") for (int r = 1; r < 16; ++r) ra_ += C0[r]; \
              _Pragma("unroll") for (int r = 0; r < 16; ++r) ra_ += C1[r]; \
              rs = ra_; lrun += rs; } \
            (void)rs; (void)rs2; \
            int pw_[8];        \
            _Pragma("unroll") for (int j = 0; j < 4; ++j) { \
                int u0_, u1_; asm volatile("" : "=v"(u0_), "=v"(u1_));        \
                int w0_ = __builtin_amdgcn_cvt_pk_bf8_f32(C0[4 * j], C0[4 * j + 1], u0_, false); w0_ = __builtin_amdgcn_cvt_pk_bf8_f32(C0[4 * j + 2], C0[4 * j + 3], w0_, true); \
                int w1_ = __builtin_amdgcn_cvt_pk_bf8_f32(C1[4 * j], C1[4 * j + 1], u1_, false); w1_ = __builtin_amdgcn_cvt_pk_bf8_f32(C1[4 * j + 2], C1[4 * j + 3], w1_, true); \
                pw_[j] = w0_; pw_[4 + j] = w1_; } \
            const i32x8_t pp_ = {pw_[0], pw_[1], pw_[2], pw_[3], pw_[4], pw_[5], pw_[6], pw_[7]}; \
            if constexpr (MSUM) asm volatile("s_nop 1\n\tv_mfma_scale_f32_32x32x64_f8f6f4 %0, %1, %2, %0, %3, %3 op_sel_hi:[0,0,0] blgp:1" : "+v"(msum_) : "v"(selA_), "v"(pp_), "v"(0x7F7F7F7F)); \
            _Pragma("unroll") for (int db = 0; db < NDB; ++db) { \
                const i32x4_t v0_ = *(const LAS i32x4_t*)(vb8_ + db * 2048), v1_ = *(const LAS i32x4_t*)((const LAS unsigned char*)((unsigned)(size_t)vb8_ ^ 16u) + db * 2048); \
                const i32x8_t va_ = {v0_.x, v0_.y, v0_.z, v0_.w, v1_.x, v1_.y, v1_.z, v1_.w}; \
                asm volatile("s_nop 1\n\tv_mfma_scale_f32_32x32x64_f8f6f4 %0, %1, %2, %0, %3, %3 op_sel_hi:[0,0,0] blgp:1" : "+v"(o[db]) : "v"(va_), "v"(pp_), "v"(0x7F7F7F7F)); } \
          } else { \
            const LAS unsigned char* vb = lds + (t_ & 3) * STAGE + VOFF + (4 * hi + ((lane & 15) >> 2)) * 64 + ((lane >> 4) & 1) * 32 + (lane & 3) * 8; \
              \
            float rs = 0.f, rs2 = 0.f; \
            bf16x8 pf[4]; \
            if constexpr (VAR == 1) { _Pragma("unroll") for (int r = 0; r < 16; ++r) { C0[r] = C0[r] * 0.001f; } } \
            else if constexpr (NEGM || FIX) { _Pragma("unroll") for (int r = 0; r < 16; ++r) { C0[r] = fast_exp2(C0[r]); } } \
            else { _Pragma("unroll") for (int r = 0; r < 16; ++r) { C0[r] = fast_exp2(C0[r] - mrel); } } \
            if constexpr (!LSUM) { _Pragma("unroll") for (int r = 0; r < 16; ++r) { rs += C0[r]; } } \
            _Pragma("unroll") for (int ks = 0; ks < 2; ++ks) { v4u w; \
                w.x = cvtpk(C0[8 * ks + 0], C0[8 * ks + 1]); w.y = cvtpk(C0[8 * ks + 2], C0[8 * ks + 3]); w.z = cvtpk(C0[8 * ks + 4], C0[8 * ks + 5]); w.w = cvtpk(C0[8 * ks + 6], C0[8 * ks + 7]); pf[ks] = __builtin_bit_cast(bf16x8, w); } \
            __builtin_amdgcn_sched_barrier(0); \
            if constexpr (VAR != 3) _Pragma("unroll") for (int db = 0; db < NDB; ++db) { \
                s16x4 vlo_[2], vhi_[2]; \
                _Pragma("unroll") for (int ks = 0; ks < 2; ++ks) { if constexpr (VAR == 8 || VAR == 9) { const bf16x8 f_ = pf[(ks + db) & 1]; vlo_[ks] = (s16x4){f_[0], f_[1], f_[2], f_[3]}; vhi_[ks] = (s16x4){f_[4], f_[5], f_[6], f_[7]}; } \
                    else { vlo_[ks] = vtr(vb + ((2 * ks) * NDB + db) * 512); vhi_[ks] = vtr(vb + ((2 * ks + 1) * NDB + db) * 512); } } \
                __builtin_amdgcn_sched_barrier(0); \
                _Pragma("unroll") for (int ks = 0; ks < 2; ++ks) { \
                    const bf16x8 vf = {vlo_[ks][0], vlo_[ks][1], vlo_[ks][2], vlo_[ks][3], vhi_[ks][0], vhi_[ks][1], vhi_[ks][2], vhi_[ks][3]}; \
                    o[db] = __builtin_amdgcn_mfma_f32_32x32x16_bf16(vf, pf[ks], o[db], 0, 0, 0); } \
                __builtin_amdgcn_sched_barrier(0); } \
            if constexpr (LSUM) { ol = __builtin_amdgcn_mfma_f32_32x32x16_bf16(ones8, pf[0], ol, 0, 0, 0); ol = __builtin_amdgcn_mfma_f32_32x32x16_bf16(ones8, pf[1], ol, 0, 0, 0); __builtin_amdgcn_sched_barrier(0); } \
              \
            if constexpr (VAR == 1) { _Pragma("unroll") for (int r = 0; r < 16; ++r) { C1[r] = C1[r] * 0.001f; } } \
            else if constexpr (NEGM || FIX) { _Pragma("unroll") for (int r = 0; r < 16; ++r) { C1[r] = fast_exp2(C1[r]); } } \
            else { _Pragma("unroll") for (int r = 0; r < 16; ++r) { C1[r] = fast_exp2(C1[r] - mrel); } } \
            if constexpr (!LSUM) { _Pragma("unroll") for (int r = 0; r < 16; ++r) { rs2 += C1[r]; } } \
            lrun += rs + rs2; \
            _Pragma("unroll") for (int ks = 0; ks < 2; ++ks) { v4u w; \
                w.x = cvtpk(C1[8 * ks + 0], C1[8 * ks + 1]); w.y = cvtpk(C1[8 * ks + 2], C1[8 * ks + 3]); w.z = cvtpk(C1[8 * ks + 4], C1[8 * ks + 5]); w.w = cvtpk(C1[8 * ks + 6], C1[8 * ks + 7]); pf[2 + ks] = __builtin_bit_cast(bf16x8, w); } \
            __builtin_amdgcn_sched_barrier(0); \
            if constexpr (VAR != 3) _Pragma("unroll") for (int db = 0; db < NDB; ++db) { \
                s16x4 vlo_[2], vhi_[2]; \
                _Pragma("unroll") for (int ks = 0; ks < 2; ++ks) { if constexpr (VAR == 8 || VAR == 9) { const bf16x8 f_ = pf[2 + ((ks + db) & 1)]; vlo_[ks] = (s16x4){f_[0], f_[1], f_[2], f_[3]}; vhi_[ks] = (s16x4){f_[4], f_[5], f_[6], f_[7]}; } \
                    else { vlo_[ks] = vtr(vb + ((2 * (ks + 2)) * NDB + db) * 512); vhi_[ks] = vtr(vb + ((2 * (ks + 2) + 1) * NDB + db) * 512); } } \
                __builtin_amdgcn_sched_barrier(0); \
                _Pragma("unroll") for (int ks = 0; ks < 2; ++ks) { \
                    const bf16x8 vf = {vlo_[ks][0], vlo_[ks][1], vlo_[ks][2], vlo_[ks][3], vhi_[ks][0], vhi_[ks][1], vhi_[ks][2], vhi_[ks][3]}; \
                    o[db] = __builtin_amdgcn_mfma_f32_32x32x16_bf16(vf, pf[2 + ks], o[db], 0, 0, 0); } \
                __builtin_amdgcn_sched_barrier(0); } \
            if constexpr (LSUM) { ol = __builtin_amdgcn_mfma_f32_32x32x16_bf16(ones8, pf[2], ol, 0, 0, 0); ol = __builtin_amdgcn_mfma_f32_32x32x16_bf16(ones8, pf[3], ol, 0, 0, 0); __builtin_amdgcn_sched_barrier(0); } \
          } \
        } \
        } \
        __builtin_amdgcn_sched_barrier(0); \
        if (act_next) pol.mask(t_ + 1, N0, N1); \
        act_cur = act_next; } while (0)
    int t = 0;
    for (; t + 1 < nt; t += 2) { FL_STEP(sa0, sa1, sb0, sb1, t); FL_STEP(sb0, sb1, sa0, sa1, t + 1); }
    if (t < nt) FL_STEP(sa0, sa1, sb0, sb1, t);
    FL_BAR();
    if constexpr (P::VF8) asm volatile("s_nop 7\n\ts_nop 7\n\ts_nop 7" ::: "memory");
    if constexpr (MSUM) lrun = (hi == 0) ? msum_[0] : 0.f;
    m_io = NEGM ? ref + mrel : mrel; l_io = LSUM ? lrun + 0.5f * ol[0] : lrun;
#undef FL_STEP
#undef FL_DMA
#undef FL_QK
}

template <int NDB>
__device__ __forceinline__ void store_o(const f32x16 (&o)[NDB], float scale, bf16* orow, int hi) {
#pragma unroll
    for (int db = 0; db < NDB; ++db)
#pragma unroll
        for (int g = 0; g < 4; ++g) {
            const unsigned lo = cvtpk(o[db][4 * g] * scale, o[db][4 * g + 1] * scale), hh = cvtpk(o[db][4 * g + 2] * scale, o[db][4 * g + 3] * scale);
            *(GAS unsigned long long*)(orow + 32 * db + 8 * g + 4 * hi) = (unsigned long long)lo | ((unsigned long long)hh << 32); }
}

template <int NDB>
__device__ __forceinline__ void store_o8(const f32x16 (&o)[NDB], float scale, unsigned char* orow, int hi) {
    const float sc = scale * O8_SCALE;
#pragma unroll
    for (int db = 0; db < NDB; ++db)
#pragma unroll
        for (int g = 0; g < 4; ++g) {
            const float y0 = __builtin_amdgcn_fmed3f(o[db][4 * g] * sc, -440.f, 440.f), y1 = __builtin_amdgcn_fmed3f(o[db][4 * g + 1] * sc, -440.f, 440.f), y2 = __builtin_amdgcn_fmed3f(o[db][4 * g + 2] * sc, -440.f, 440.f), y3 = __builtin_amdgcn_fmed3f(o[db][4 * g + 3] * sc, -440.f, 440.f);
            int wd = __builtin_amdgcn_cvt_pk_fp8_f32(y0, y1, 0, false); wd = __builtin_amdgcn_cvt_pk_fp8_f32(y2, y3, wd, true);
            *(GAS int*)(orow + 32 * db + 8 * g + 4 * hi) = wd; }
}

#ifndef FORCE_SAFE_SOFTMAX
#define FORCE_SAFE_SOFTMAX 0
#endif
struct PolMLA {
    static constexpr bool KF8 = true, VF8 = true, HL = false, MSUM_OK = true; static constexpr bool LSUM = false; static constexpr int DQK = 96, DV = 64, PPW = 2, STAGE = 24576, VOFF = 16384; static constexpr bool NEGM = false;
    const unsigned char* g0; const bf16* g1; int ntiles;
    static __device__ __forceinline__ int keyof(int row) { const int mrow = row & 31, cc = 32 * ((mrow >> 2) & 1) + 16 * (row >> 5) + (mrow & 3) + 4 * (mrow >> 3); return 16 * (cc & 3) + (cc >> 2); }
    __device__ __forceinline__ void init(const unsigned char* kn8  , const bf16* kr, const unsigned char* vt, int w, int lane) {
        const int row = 8 * w + (lane >> 3), c = (lane & 7) ^ ((row >> 1) & 7);
        const int r8 = 16 * (w & 3) + (lane >> 2), c8 = (lane & 3) ^ ((r8 >> 2) & 3);
        g0 = (w < 4) ? kn8 + (size_t)keyof(r8) * 2048 + 16 * c8 : vt + (size_t)r8 * SEQ + 16 * c8;
        g1 = kr + (size_t)keyof(row) * 768 + 8 * c; }
    __device__ __forceinline__ void dma(int t, LAS unsigned char* st, int w, int lane) const {
        if (w < 4) dma16(g0 + (size_t)t * (64 * 2048), st + w * 1024); else dma16(g0 + t * 64, st + 16384 + (w - 4) * 1024);
        dma16(g1 + (size_t)t * (64 * 768), st + 8192 + w * 1024);
    }
    __device__ __forceinline__ bool active(int) const { return true; }
    __device__ __forceinline__ void mask(int, f32x16&, f32x16&) const {}
};
template <int VAR = 0>
__device__ __forceinline__ void mla_unit(unsigned char* ws, LAS unsigned char* lds, int b, int h, int qb, int wave_, int lane_) {
    int tidl_ = threadIdx.x; asm volatile("" : "+v"(tidl_)); const int lane = tidl_ & 63, wave = __builtin_amdgcn_readfirstlane(tidl_ >> 6); (void)lane_;
    const int r32 = lane & 31, hi = lane >> 5; const size_t row = (size_t)b * SEQ + qb * 256 + wave * 32 + r32;
    bf16* qn = (bf16*)(ws + WS_MQN) + row * 512 + h * 64; const bf16* qr = (const bf16*)(ws + WS_MQR) + row * 256 + h * 32;
    bf16x8 qf[6];
    { const bf16* qs = qn + 32 * hi; int w8[8];
#pragma unroll
      for (int s = 0; s < 4; ++s) { const v4u raw = *(const GAS v4u*)(qs + 8 * s);
          int lo = __builtin_amdgcn_cvt_pk_fp8_f32(bf_lo(raw.x), bf_hi(raw.x), 0, false); lo = __builtin_amdgcn_cvt_pk_fp8_f32(bf_lo(raw.y), bf_hi(raw.y), lo, true);
          int hi2 = __builtin_amdgcn_cvt_pk_fp8_f32(bf_lo(raw.z), bf_hi(raw.z), 0, false); hi2 = __builtin_amdgcn_cvt_pk_fp8_f32(bf_lo(raw.w), bf_hi(raw.w), hi2, true);
          w8[2 * s] = lo; w8[2 * s + 1] = hi2; }
      const i32x4_t f0 = {w8[0], w8[1], w8[2], w8[3]}, f1 = {w8[4], w8[5], w8[6], w8[7]};
      qf[0] = __builtin_bit_cast(bf16x8, f0); qf[1] = __builtin_bit_cast(bf16x8, f1); qf[2] = qf[0]; qf[3] = qf[1]; }
#pragma unroll
    for (int s = 0; s < 2; ++s) {
        const v4u raw = *(const GAS v4u*)(qr + 16 * s + 8 * hi);
        float x[8] = {bf_lo(raw.x), bf_hi(raw.x), bf_lo(raw.y), bf_hi(raw.y), bf_lo(raw.z), bf_hi(raw.z), bf_lo(raw.w), bf_hi(raw.w)};
        rope4(x, (const f32x2*)(ws + WS_ROPE32) + (size_t)(qb * 256 + wave * 32 + r32) * 16 + 8 * s + 4 * hi);
        v4u w; w.x = cvtpk(x[0], x[1]); w.y = cvtpk(x[2], x[3]); w.z = cvtpk(x[4], x[5]); w.w = cvtpk(x[6], x[7]);
        qf[4 + s] = __builtin_bit_cast(bf16x8, w); }
    PolMLA pol; pol.init(ws + WS_KVB + (size_t)b * SEQ * 2048 + h * 64, (const bf16*)(ws + WS_LAT) + (size_t)b * SEQ * 768 + 640,
                         ws + WS_DIFV + 16 * MiB + (size_t)(b * 8 + h) * 64 * SEQ, wave, lane); pol.ntiles = SEQ / 64;
    f32x16 o[2];
#pragma unroll
    for (int r = 0; r < 16; ++r) { o[0][r] = 0.f; o[1][r] = 0.f; }
    float m = -1e30f, l = 0.f;
    flash_run<PolMLA, VAR, true>(pol, lds, qf, o, m, l);
    l = halves_sum(l);
    if (__any(!(l > 1e-30f && l < 1e25f) || FORCE_SAFE_SOFTMAX)) {
#pragma unroll
        for (int r = 0; r < 16; ++r) { o[0][r] = 0.f; o[1][r] = 0.f; }
        m = -1e30f; l = 0.f;
        flash_run<PolMLA, VAR, false>(pol, lds, qf, o, m, l);
        l = halves_sum(l);
    }
    { int tid2_ = threadIdx.x; asm volatile("" : "+v"(tid2_)); const int lane2 = tid2_ & 63, wave2 = __builtin_amdgcn_readfirstlane(tid2_ >> 6);
      unsigned char* o8 = ws + WS_U + (size_t)wave_ * 32 * MiB + 16 * MiB + ((size_t)b * SEQ + qb * 256 + wave2 * 32 + (lane2 & 31)) * 512 + h * 64;
      store_o8<2>(o, fast_rcp(l), o8, lane2 >> 5); }
}

struct PolDiff {
    static constexpr bool KF8 = true, VF8 = true, HL = true, MSUM_OK = true; static constexpr bool LSUM = false; static constexpr int DQK = 64, DV = 128, PPW = 2, STAGE = 24576, VOFF = 8192; static constexpr bool NEGM = false;
    const unsigned char* g0; const unsigned char* g1; int ntiles;
    __device__ __forceinline__ void init(const unsigned char* k8, const unsigned char* vt, int w, int lane) {
        const int row = 16 * (w & 3) + (lane >> 2), c = (lane & 3) ^ ((row >> 2) & 3);
        const int mrow = row & 31, cc = 32 * ((mrow >> 2) & 1) + 16 * (row >> 5) + (mrow & 3) + 4 * (mrow >> 3), key = 16 * (cc & 3) + (cc >> 2);
        g0 = k8 + (size_t)key * 512 + 16 * c;
        const int drow = 16 * w + (lane >> 2), vc = (lane & 3) ^ ((drow >> 2) & 3); g1 = vt + (size_t)drow * SEQ + 16 * vc; }
    __device__ __forceinline__ void dma(int t, LAS unsigned char* st, int w, int lane) const {
        if (w < 4) dma16(g0 + (size_t)t * (64 * 512), st + w * 1024);
        dma16(g1 + t * 64, st + 8192 + w * 1024);
    }
    __device__ __forceinline__ bool active(int) const { return true; }
    __device__ __forceinline__ void mask(int, f32x16&, f32x16&) const {}
};
template <int VAR = 0>
__device__ __forceinline__ void diff_unit(unsigned char* ws, LAS unsigned char* lds, int b, int h, int qb, int wave_, int lane_, const float* lq1, const float* lk1, const float* lq2, const float* lk2, float lam_init, const float* subln) {
    (void)wave_; (void)lane_;
#define DIFF_IDS int tidl_ = threadIdx.x; asm volatile("" : "+v"(tidl_)); const int lane = tidl_ & 63, wave = __builtin_amdgcn_readfirstlane(tidl_ >> 6); const int r32 = lane & 31, hi = lane >> 5; \
        const size_t row = (size_t)b * SEQ + qb * 256 + wave * 32 + r32; bf16* q = (bf16*)(ws + WS_DIFQ) + row * 512 + h * 128; \
        bf16* scr = (bf16*)(ws + WS_DSCR) + ((size_t)blockIdx.x * 256 + wave * 32 + r32) * 128; (void)q; (void)scr; (void)hi;
    for (int mp = 0; mp < 2; ++mp) {
        bf16x8 qf[4]; PolDiff pol;
        { DIFF_IDS
          { const bf16* qs = q + 64 * mp + 32 * hi; int w8[8];
#pragma unroll
            for (int s = 0; s < 4; ++s) { const v4u raw = *(const GAS v4u*)(qs + 8 * s);
                int lo = __builtin_amdgcn_cvt_pk_fp8_f32(bf_lo(raw.x), bf_hi(raw.x), 0, false); lo = __builtin_amdgcn_cvt_pk_fp8_f32(bf_lo(raw.y), bf_hi(raw.y), lo, true);
                int hi2 = __builtin_amdgcn_cvt_pk_fp8_f32(bf_lo(raw.z), bf_hi(raw.z), 0, false); hi2 = __builtin_amdgcn_cvt_pk_fp8_f32(bf_lo(raw.w), bf_hi(raw.w), hi2, true);
                w8[2 * s] = lo; w8[2 * s + 1] = hi2; }
            const i32x4_t f0 = {w8[0], w8[1], w8[2], w8[3]}, f1 = {w8[4], w8[5], w8[6], w8[7]};
            qf[0] = __builtin_bit_cast(bf16x8, f0); qf[1] = __builtin_bit_cast(bf16x8, f1); qf[2] = qf[0]; qf[3] = qf[1]; }
          pol.init(ws + WS_DIFK + (size_t)b * SEQ * 512 + h * 128 + 64 * mp, ws + WS_DIFV + (size_t)(b * 4 + h) * 128 * SEQ, wave, lane); pol.ntiles = SEQ / 64; }
        f32x16 o[4];
#pragma unroll
        for (int d = 0; d < 4; ++d)
#pragma unroll
            for (int r = 0; r < 16; ++r) o[d][r] = 0.f;
        float m = -1e30f, l = 0.f;
        flash_run<PolDiff, VAR, true>(pol, lds, qf, o, m, l);
        l = halves_sum(l);
        if (__any(!(l > 1e-30f && l < 1e25f) || FORCE_SAFE_SOFTMAX)) {
#pragma unroll
            for (int d = 0; d < 4; ++d)
#pragma unroll
                for (int r = 0; r < 16; ++r) o[d][r] = 0.f;
            m = -1e30f; l = 0.f;
            flash_run<PolDiff, VAR, false>(pol, lds, qf, o, m, l);
            l = halves_sum(l);
        }
        const float il = fast_rcp(l);
        DIFF_IDS
        if (mp == 0) {
            store_o<4>(o, il, scr, hi);
            asm volatile("s_waitcnt vmcnt(0)" ::: "memory");
        } else {
            const float lam = expf(wave_sum(lq1[lane] * lk1[lane])) - expf(wave_sum(lq2[lane] * lk2[lane])) + lam_init; const float post = 1.f - lam_init;
            const float il2 = lam * il; float ss = 0.f;
#pragma unroll
            for (int d = 0; d < 4; ++d)
#pragma unroll
                for (int g = 0; g < 4; ++g) { const unsigned long long w = *(const GAS unsigned long long*)(scr + 32 * d + 8 * g + 4 * hi); const unsigned w0 = (unsigned)w, w1 = (unsigned)(w >> 32);
                    o[d][4 * g] = bf_lo(w0) - il2 * o[d][4 * g]; o[d][4 * g + 1] = bf_hi(w0) - il2 * o[d][4 * g + 1]; o[d][4 * g + 2] = bf_lo(w1) - il2 * o[d][4 * g + 2]; o[d][4 * g + 3] = bf_hi(w1) - il2 * o[d][4 * g + 3];
                    ss += o[d][4 * g] * o[d][4 * g] + o[d][4 * g + 1] * o[d][4 * g + 1] + o[d][4 * g + 2] * o[d][4 * g + 2] + o[d][4 * g + 3] * o[d][4 * g + 3]; }
            ss = halves_sum(ss);
            const float rn = post / sqrtf(ss * (1.f / 128.f) + LN_EPS);
#pragma unroll
            for (int d = 0; d < 4; ++d)
#pragma unroll
                for (int g = 0; g < 4; ++g) { const f32x4 gv = *(const GAS f32x4*)(subln + 32 * d + 8 * g + 4 * hi);
                    o[d][4 * g] *= gv.x; o[d][4 * g + 1] *= gv.y; o[d][4 * g + 2] *= gv.z; o[d][4 * g + 3] *= gv.w; }
            store_o8<4>(o, rn, ws + WS_LAT + row * 1536 + h * 128, hi);
        }
    }
#undef DIFF_IDS
}

struct PolSWA {
    static constexpr bool KF8 = false, VF8 = false, HL = false, MSUM_OK = false; static constexpr bool LSUM = false; static constexpr int DQK = 64, DV = 64, PPW = 2, STAGE = 16384, VOFF = 8192; static constexpr bool NEGM = true;
    const bf16 *k, *v; int ntiles; int kv0; int qw; int q;
    int hi;
    __device__ __forceinline__ int kvrow(int t, int row) const { int kv = kv0 + t * 64 + row; kv = kv < 0 ? 0 : kv; return kv > SEQ - 1 ? SEQ - 1 : kv; }
    __device__ __forceinline__ void dma(int t, LAS unsigned char* st, int w, int lane) const {
        const int row = 8 * w + (lane >> 3), c = (lane & 7) ^ ((row >> 1) & 7);
        dma16(k + (size_t)kvrow(t, row) * 256 + 8 * c, st + w * 1024);
        const int sub = 2 * w + (lane >> 5), vrow = 8 * (sub >> 1) + ((lane >> 2) & 7), vc = 32 * (sub & 1) + 8 * (lane & 3);
        dma16(v + (size_t)kvrow(t, vrow) * 256 + vc, st + 8192 + w * 1024);
    }
    __device__ __forceinline__ bool active(int t) const { const int lo = kv0 + t * 64; return (lo + 63 >= qw - 128) && (lo <= qw + 31 + 128) && (lo + 63 >= 0) && (lo < SEQ); }
    __device__ __forceinline__ void mask(int t, f32x16& p0, f32x16& p1) const {
        const int lo = kv0 + t * 64;
#pragma unroll
        for (int r = 0; r < 16; ++r) { const int kv = lo + crow(r, hi); const int d0 = q - kv, d1 = d0 - 32;
            if (d0 > 128 || d0 < -128 || kv < 0 || kv >= SEQ) p0[r] = -INFINITY;
            if (d1 > 128 || d1 < -128 || kv + 32 < 0 || kv + 32 >= SEQ) p1[r] = -INFINITY; }
    }
};
__device__ __forceinline__ void swa_unit(unsigned char* ws, LAS unsigned char* lds, int b, int h, int qb, int wave_, int lane_, float sink2) {
    int tidl_ = threadIdx.x; asm volatile("" : "+v"(tidl_)); const int lane = tidl_ & 63, wave = __builtin_amdgcn_readfirstlane(tidl_ >> 6); (void)wave_; (void)lane_;
    const int r32 = lane & 31, hi = lane >> 5; const int qw = qb * 256 + wave * 32; const size_t row = (size_t)b * SEQ + qw + r32;
    bf16* q = (bf16*)(ws + WS_SWAQ) + row * 512 + h * 64;
    bf16x8 qf[4];
#pragma unroll
    for (int s = 0; s < 4; ++s) qf[s] = *(const GAS bf16x8*)(q + 16 * s + 8 * hi);
    PolSWA pol; pol.k = (const bf16*)(ws + WS_SWAKV) + (size_t)b * SEQ * 256 + (h >> 2) * 64; pol.v = pol.k + 128;
    pol.ntiles = 8; pol.kv0 = qb * 256 - 128; pol.qw = qw; pol.q = qw + r32; pol.hi = hi;
    f32x16 o[2];
#pragma unroll
    for (int r = 0; r < 16; ++r) { o[0][r] = 0.f; o[1][r] = 0.f; }
    float m = -1e30f, l = 0.f;
    flash_run<PolSWA, 0, true>(pol, lds, qf, o, m, l);
    l = halves_sum(l) + fast_exp2(sink2);
    if (__any(!(l > 1e-30f && l < 1e25f) || FORCE_SAFE_SOFTMAX)) {
#pragma unroll
        for (int r = 0; r < 16; ++r) { o[0][r] = 0.f; o[1][r] = 0.f; }
        m = -1e30f; l = 0.f;
        flash_run<PolSWA, 0, false>(pol, lds, qf, o, m, l);
        l = halves_sum(l) + fast_exp2(sink2 - m);
    }
    store_o8<2>(o, fast_rcp(l), ws + WS_U + (size_t)wave_ * 32 * MiB + row * 512 + h * 64, hi);
}

struct PolNAT {
    static constexpr bool KF8 = false, VF8 = false, HL = false, MSUM_OK = false; static constexpr bool LSUM = false; static constexpr int DQK = 64, DV = 64, PPW = 2, STAGE = 16384, VOFF = 8192; static constexpr bool NEGM = true;
    const bf16 *k, *v; int ntiles; int tr0; int r; int j; int hi; const LAS float* bias;
    __device__ __forceinline__ void dma(int t, LAS unsigned char* st, int w, int lane) const {
        const int row = 8 * w + (lane >> 3), c = (lane & 7) ^ ((row >> 1) & 7);
        dma16(k + ((size_t)(tr0 + t) * 64 + row) * 512 + 8 * c, st + w * 1024);
        const int sub = 2 * w + (lane >> 5), vrow = 8 * (sub >> 1) + ((lane >> 2) & 7), vc = 32 * (sub & 1) + 8 * (lane & 3);
        dma16(v + ((size_t)(tr0 + t) * 64 + vrow) * 512 + vc, st + 8192 + w * 1024);
    }
    __device__ __forceinline__ int r0() const { int x = r - 4; x = x < 0 ? 0 : x; return x > 120 ? 120 : x; }
    __device__ __forceinline__ bool active(int t) const { const int kr = tr0 + t, a = r0(); return kr >= a && kr < a + 8; }
    __device__ __forceinline__ void mask(int t, f32x16& p0, f32x16& p1) const {
        int c0 = j - 8; c0 = c0 < 0 ? 0 : c0; c0 = c0 > 48 ? 48 : c0;
        const LAS float* brow = bias + ((tr0 + t) - r + 7) * 31 + (15 - j);
#pragma unroll
        for (int rr = 0; rr < 16; ++rr) { const int kc = crow(rr, hi);
            p0[rr] = (kc >= c0 && kc < c0 + 16) ? p0[rr] + brow[kc] : -INFINITY;
            p1[rr] = (kc + 32 >= c0 && kc + 32 < c0 + 16) ? p1[rr] + brow[kc + 32] : -INFINITY; }
    }
};
__device__ __forceinline__ void nat_unit(unsigned char* ws, LAS unsigned char* lds, const LAS float* bias_all, int b, int h, int rg, int wave_, int lane_) {
    int tidl_ = threadIdx.x; asm volatile("" : "+v"(tidl_)); const int lane = tidl_ & 63, wave = __builtin_amdgcn_readfirstlane(tidl_ >> 6); (void)wave_; (void)lane_;
    const int r32 = lane & 31, hi = lane >> 5; const int r = 4 * rg + (wave >> 1), j = 32 * (wave & 1) + r32; const size_t row = (size_t)b * SEQ + r * 64 + j;
    bf16* q = (bf16*)(ws + WS_NATQ) + row * 512 + h * 64;
    bf16x8 qf[4];
#pragma unroll
    for (int s = 0; s < 4; ++s) qf[s] = *(const GAS bf16x8*)(q + 16 * s + 8 * hi);
    int ra = 4 * rg - 4; ra = ra < 0 ? 0 : ra; ra = ra > 120 ? 120 : ra; int rb = 4 * rg - 1; rb = rb < 0 ? 0 : rb; rb = rb > 120 ? 120 : rb;
    PolNAT pol; pol.k = (const bf16*)(ws + WS_NATK) + (size_t)b * SEQ * 512 + h * 64; pol.v = (const bf16*)(ws + WS_NATV) + (size_t)b * SEQ * 512 + h * 64;
    pol.tr0 = ra; pol.ntiles = rb + 7 - ra + 1; pol.r = r; pol.j = j; pol.hi = hi; pol.bias = bias_all + h * 465;
    f32x16 o[2];
#pragma unroll
    for (int rr = 0; rr < 16; ++rr) { o[0][rr] = 0.f; o[1][rr] = 0.f; }
    float m = -1e30f, l = 0.f;
    flash_run<PolNAT, 0, true>(pol, lds, qf, o, m, l);
    l = halves_sum(l);
    if (__any(!(l > 1e-30f && l < 1e25f) || FORCE_SAFE_SOFTMAX)) {
#pragma unroll
        for (int rr = 0; rr < 16; ++rr) { o[0][rr] = 0.f; o[1][rr] = 0.f; }
        m = -1e30f; l = 0.f;
        flash_run<PolNAT, 0, false>(pol, lds, qf, o, m, l);
        l = halves_sum(l);
    }
    store_o8<2>(o, fast_rcp(l), ws + WS_LAT + row * 1536 + 512 + h * 64, hi);
}


__device__ __forceinline__ unsigned f2key(float f) { const unsigned u = __float_as_uint(f); return (u & 0x80000000u) ? ~u : (u | 0x80000000u); }
__device__ __forceinline__ float key2f(unsigned k) { const unsigned u = (k & 0x80000000u) ? (k & 0x7fffffffu) : ~k; return __uint_as_float(u); }
__device__ __forceinline__ unsigned umax2(unsigned a, unsigned b) { return a > b ? a : b; }
__device__ __forceinline__ unsigned zero_if_eq(unsigned k, unsigned M) { unsigned r; asm("v_cmp_ne_u32_e32 vcc, %1, %2\n\tv_cndmask_b32_e32 %0, 0, %1, vcc" : "=v"(r) : "v"(k), "v"(M) : "vcc"); return r; }
__device__ __forceinline__ void take_if_eq(unsigned& p, unsigned& k, unsigned M, unsigned pay) { unsigned nk; asm("v_cmp_eq_u32_e32 vcc, %2, %3\n\tv_cndmask_b32_e32 %0, %0, %4, vcc\n\tv_cndmask_b32_e64 %1, %2, 0, vcc" : "+v"(p), "=&v"(nk) : "v"(k), "v"(M), "v"(pay) : "vcc"); k = nk; }

#define SN_CE(k, a_, b_) do { const unsigned x_ = k[a_], y_ = k[b_]; k[a_] = x_ > y_ ? x_ : y_; k[b_] = x_ > y_ ? y_ : x_; } while (0)
template <int OFF, int N>
__device__ __forceinline__ void sn_sort16_desc(unsigned (&k)[N]) {
#pragma unroll
    for (int kk = 2; kk <= 16; kk <<= 1)
#pragma unroll
        for (int j = kk >> 1; j > 0; j >>= 1)
#pragma unroll
            for (int i = 0; i < 16; ++i) { const int l = i ^ j; if (l > i) { if ((i & kk) == 0) SN_CE(k, OFF + i, OFF + l); else SN_CE(k, OFF + l, OFF + i); } }
}
template <int OFF, int N>
__device__ __forceinline__ void sn_bmerge16_desc(unsigned (&k)[N]) {
#pragma unroll
    for (int j = 8; j > 0; j >>= 1)
#pragma unroll
        for (int i = 0; i < 16; ++i) { const int l = i ^ j; if (l > i) SN_CE(k, OFF + i, OFF + l); }
}
template <int A, int B, int N>
__device__ __forceinline__ void sn_merge16(unsigned (&k)[N]) {
#pragma unroll
    for (int i = 0; i < 16; ++i) { const unsigned x_ = k[A + i], y_ = k[B + 15 - i]; k[A + i] = x_ > y_ ? x_ : y_; }
    sn_bmerge16_desc<A>(k);
}

__device__ __forceinline__ void peer_route_unit(unsigned char* ws, LAS unsigned char* lds, int tile, int h, int wave, int lane, bool load_keys  ) {
    int tid = threadIdx.x; asm volatile("" : "+v"(tid)); const int r32 = lane & 31, hi = lane >> 5;
    constexpr int KSTR = 272;
    const bf16* keys = (const bf16*)(ws + WS_KEYS) + (size_t)h * 2 * 128 * 128;
    if (load_keys) {
        __syncthreads();
        for (int i = tid; i < 2 * 128 * 16; i += NTHR) { const int row = i >> 4, ch = i & 15; *(LAS v4u*)(lds + row * KSTR + ch * 16) = *(const GAS v4u*)(keys + (size_t)row * 128 + ch * 8); }
        __syncthreads();
    }
    const size_t tok = (size_t)tile * 256 + wave * 32 + r32;
    const bf16* q = (const bf16*)(ws + WS_QP) + tok * 2048 + h * 256;
    unsigned list[2][16];
#pragma unroll
    for (int p = 0; p < 2; ++p) {
        bf16x8 qf[8];
#pragma unroll
        for (int s = 0; s < 8; ++s) qf[s] = *(const GAS bf16x8*)(q + p * 128 + 16 * s + 8 * hi);
        unsigned key[64];
#pragma unroll
        for (int nb = 0; nb < 4; ++nb) {
            f32x16 acc;
#pragma unroll
            for (int r = 0; r < 16; ++r) acc[r] = 0.f;
            const LAS unsigned char* kb = lds + (p * 128 + 32 * nb + r32) * KSTR + hi * 16;
#pragma unroll
            for (int s = 0; s < 8; ++s) acc = __builtin_amdgcn_mfma_f32_32x32x16_bf16(*(const LAS bf16x8*)(kb + s * 32), qf[s], acc, 0, 0, 0);
#pragma unroll
            for (int r = 0; r < 16; ++r) { const int n = 32 * nb + crow(r, hi); key[nb * 16 + r] = (f2key(acc[r]) & ~127u) | (unsigned)(127 - n); }
        }
        sn_sort16_desc<0>(key); sn_sort16_desc<16>(key); sn_sort16_desc<32>(key); sn_sort16_desc<48>(key);
        sn_merge16<0, 16>(key); sn_merge16<32, 48>(key); sn_merge16<0, 32>(key);
        unsigned c16[16];
#pragma unroll
        for (int i = 0; i < 16; ++i) { const unsigned mine = key[15 - i]; auto rr = __builtin_amdgcn_permlane32_swap(mine, mine, false, false); const unsigned other = hi ? rr[0] : rr[1];
            c16[i] = key[i] > other ? key[i] : other; }
        sn_bmerge16_desc<0>(c16);
#pragma unroll
        for (int rd = 0; rd < 16; ++rd) list[p][rd] = c16[rd];
    }
    constexpr int CA[50] = {0,0,0,0,0,0,0,0,0,0,0,0,0,0,0,0, 1,1,1,1,1,1,1,1, 2,2,2,2,2, 3,3,3,3, 4,4,4, 5,5, 6,6, 7,7, 8,9,10,11,12,13,14,15};
    constexpr int CB[50] = {0,1,2,3,4,5,6,7,8,9,10,11,12,13,14,15, 0,1,2,3,4,5,6,7, 0,1,2,3,4, 0,1,2,3, 0,1,2, 0,1, 0,1, 0,1, 0,0,0,0,0,0,0,0};
    unsigned ck[50], pay[50];
#pragma unroll
    for (int c = 0; c < 50; ++c) { const unsigned ka = list[0][CA[c]], kb2 = list[1][CB[c]];
        const float s = key2f(ka & ~127u) + key2f(kb2 & ~127u);
        ck[c] = (f2key(s) & ~63u) | (unsigned)(63 - c); pay[c] = ((127u - (ka & 127u)) << 7) | (127u - (kb2 & 127u)); }
    float ss[16]; unsigned sp[16];
#pragma unroll
    for (int rd = 0; rd < 16; ++rd) {
        unsigned mx = ck[0];
#pragma unroll
        for (int c = 1; c < 50; ++c) mx = umax2(mx, ck[c]);
        unsigned pp = 0u;
#pragma unroll
        for (int c = 0; c < 50; ++c) take_if_eq(pp, ck[c], mx, pay[c]);
        ss[rd] = key2f(mx & ~63u); sp[rd] = pp;
    }
    float sum = 0.f;
    const float smax = ss[0];
#pragma unroll
    for (int k = 0; k < 16; ++k) { ss[k] = __expf(ss[k] - smax); sum += ss[k]; }
    const float inv = 1.f / sum;
    if (hi == 0) {
        int* pi = (int*)(ws + WS_PIDX) + tok * 128 + h * 16; float* pg = (float*)(ws + WS_PGATE) + tok * 128 + h * 16;
#pragma unroll
        for (int k = 0; k < 16; k += 4) { v4u iv; iv.x = sp[k]; iv.y = sp[k + 1]; iv.z = sp[k + 2]; iv.w = sp[k + 3]; *(GAS v4u*)(pi + k) = iv;
            f32x4 gv; gv.x = ss[k] * inv; gv.y = ss[k + 1] * inv; gv.z = ss[k + 2] * inv; gv.w = ss[k + 3] * inv; *(GAS f32x4*)(pg + k) = gv; }
    }
}

typedef unsigned v2u __attribute__((ext_vector_type(2)));
__device__ __forceinline__ void fp4_row(const f32x4 (&v)[4], unsigned char* dst, float* scale_out, int lane) {
    float amax = 0.f;
#pragma unroll
    for (int k = 0; k < 4; ++k) { amax = fmaxf(amax, fmaxf(fmaxf(fabsf(v[k].x), fabsf(v[k].y)), fmaxf(fabsf(v[k].z), fabsf(v[k].w)))); }
    amax = wave_max(amax);
    const float sc = amax > 0.f ? amax * (1.f / 6.f) : 1.f, inv = 1.f / sc;
    v2u w;
    { unsigned p = 0; p = __builtin_amdgcn_cvt_scalef32_pk_fp4_f32(p, v[0].x * inv, v[0].y * inv, 1.f, 0); p = __builtin_amdgcn_cvt_scalef32_pk_fp4_f32(p, v[0].z * inv, v[0].w * inv, 1.f, 1);
      p = __builtin_amdgcn_cvt_scalef32_pk_fp4_f32(p, v[1].x * inv, v[1].y * inv, 1.f, 2); p = __builtin_amdgcn_cvt_scalef32_pk_fp4_f32(p, v[1].z * inv, v[1].w * inv, 1.f, 3); w.x = p; }
    { unsigned p = 0; p = __builtin_amdgcn_cvt_scalef32_pk_fp4_f32(p, v[2].x * inv, v[2].y * inv, 1.f, 0); p = __builtin_amdgcn_cvt_scalef32_pk_fp4_f32(p, v[2].z * inv, v[2].w * inv, 1.f, 1);
      p = __builtin_amdgcn_cvt_scalef32_pk_fp4_f32(p, v[3].x * inv, v[3].y * inv, 1.f, 2); p = __builtin_amdgcn_cvt_scalef32_pk_fp4_f32(p, v[3].z * inv, v[3].w * inv, 1.f, 3); w.y = p; }
    *(GAS v2u*)(dst + 8 * lane) = w;
    if (lane == 0) *scale_out = sc;
}
__device__ __forceinline__ void fp4_row_nat(const f32x4 (&v)[4], unsigned char* dst, float* scale_out, int lane) {
    float amax = 0.f;
#pragma unroll
    for (int k = 0; k < 4; ++k) { amax = fmaxf(amax, fmaxf(fmaxf(fabsf(v[k].x), fabsf(v[k].y)), fmaxf(fabsf(v[k].z), fabsf(v[k].w)))); }
    amax = wave_max(amax);
    const float sc = amax > 0.f ? amax * (1.f / 6.f) : 1.f, inv = 1.f / sc;
#pragma unroll
    for (int k = 0; k < 4; ++k) { unsigned p = 0; p = __builtin_amdgcn_cvt_scalef32_pk_fp4_f32(p, v[k].x * inv, v[k].y * inv, 1.f, 0); p = __builtin_amdgcn_cvt_scalef32_pk_fp4_f32(p, v[k].z * inv, v[k].w * inv, 1.f, 1);
        *(GAS unsigned short*)(dst + 128 * k + 2 * lane) = (unsigned short)p; }
    if (lane == 0) *scale_out = sc;
}
__device__ __forceinline__ f32x2 dot8_fp4(unsigned q, const f32x2* x2, f32x2 acc) {
    const f32x2 a = __builtin_amdgcn_cvt_scalef32_pk_f32_fp4(q, 1.f, 0), b = __builtin_amdgcn_cvt_scalef32_pk_f32_fp4(q, 1.f, 1), c = __builtin_amdgcn_cvt_scalef32_pk_f32_fp4(q, 1.f, 2), d = __builtin_amdgcn_cvt_scalef32_pk_f32_fp4(q, 1.f, 3);
    acc = __builtin_elementwise_fma(a, x2[0], acc); acc = __builtin_elementwise_fma(b, x2[1], acc); acc = __builtin_elementwise_fma(c, x2[2], acc); acc = __builtin_elementwise_fma(d, x2[3], acc);
    return acc;
}
__device__ __forceinline__ void axpy8_fp4(float* o, float w, unsigned q) {
    const f32x2 a = __builtin_amdgcn_cvt_scalef32_pk_f32_fp4(q, 1.f, 0), b = __builtin_amdgcn_cvt_scalef32_pk_f32_fp4(q, 1.f, 1), c = __builtin_amdgcn_cvt_scalef32_pk_f32_fp4(q, 1.f, 2), d = __builtin_amdgcn_cvt_scalef32_pk_f32_fp4(q, 1.f, 3);
    o[0] += w * a.x; o[1] += w * a.y; o[2] += w * b.x; o[3] += w * b.y; o[4] += w * c.x; o[5] += w * c.y; o[6] += w * d.x; o[7] += w * d.y;
}
__device__ __forceinline__ void peer_token8(LAS unsigned char* xl  , unsigned char* ws, float* xio, const float* gffn, const float* lng, const float* lnb, const float* mod_next  , unsigned char* u8_next  , size_t tok, int lane) {
    const bf16* u2 = (const bf16*)(ws + WS_U2) + tok * 1024;
    float x[16];
#pragma unroll
    for (int k = 0; k < 4; ++k) { const unsigned long long w = *(const GAS unsigned long long*)(u2 + 256 * k + 4 * lane); const unsigned w0 = (unsigned)w, w1 = (unsigned)(w >> 32);
        x[4 * k] = bf_lo(w0); x[4 * k + 1] = bf_hi(w0); x[4 * k + 2] = bf_lo(w1); x[4 * k + 3] = bf_hi(w1); }
    f32x2 x2[8];
#pragma unroll
    for (int i = 0; i < 8; ++i) { x2[i].x = x[2 * i]; x2[i].y = x[2 * i + 1]; }
#pragma unroll
    for (int k = 0; k < 4; ++k) { int wd = __builtin_amdgcn_cvt_pk_fp8_f32(x[4 * k] * 2.f, x[4 * k + 1] * 2.f, 0, false); wd = __builtin_amdgcn_cvt_pk_fp8_f32(x[4 * k + 2] * 2.f, x[4 * k + 3] * 2.f, wd, true);
        *(LAS int*)(xl + 256 * k + 4 * lane) = wd; }
    const int* pi = (const int*)(ws + WS_PIDX) + tok * 128; const float* pg = (const float*)(ws + WS_PGATE) + tok * 128;
    const float* sus = (const float*)(ws + WS_TSCALE); const float* svs = sus + 16384;
    const int ia = pi[lane], ib = pi[64 + lane];
    const float ga = pg[lane] * svs[ia], gb = pg[64 + lane] * svs[ib];
    const float ua_s = sus[ia], ub_s = sus[ib];
    const unsigned char* vt = ws + WS_VTAB + 8 * lane;
    float out[16];
#pragma unroll
    for (int i = 0; i < 16; ++i) out[i] = 0.f;
    const int el = lane & 15, g4 = lane >> 4;
    typedef int v4i_t __attribute__((ext_vector_type(4))); typedef int v8i_t __attribute__((ext_vector_type(8)));
    v4i_t ua[8]; v2u qv[16];
#define PK_IDX(eb_) const int ebl_ = (eb_); const int srcl_ = ebl_ < 4 ? ia : ib; const int basel_ = (ebl_ & 3) * 16; int e_[16]; \
        _Pragma("unroll") for (int j = 0; j < 16; ++j) e_[j] = __builtin_amdgcn_readlane(srcl_, basel_ + j);
#define PK_LOADU(eb_) do { const int ebl_ = (eb_); const int mine_ = shl_i(ebl_ < 4 ? ia : ib, (ebl_ & 3) * 16 + el); const unsigned char* up_ = ws + WS_UTAB + (size_t)mine_ * 512 + 16 * g4; \
        _Pragma("unroll") for (int c = 0; c < 8; ++c) ua[c] = *(const GAS v4i_t*)(up_ + 64 * c); } while (0)
#define PK_LOADV(eb_) do { PK_IDX(eb_) _Pragma("unroll") for (int j = 0; j < 16; ++j) qv[j] = *(const GAS v2u*)(vt + (size_t)e_[j] * 512); } while (0)
    PK_LOADU(0);
#pragma unroll 1
    for (int eb = 0; eb < 8; ++eb) {
        const float gsrc = eb < 4 ? ga : gb, ssrc = eb < 4 ? ua_s : ub_s; const int base = (eb & 3) * 16;
        PK_LOADV(eb);
        f32x4 acc = {0.f, 0.f, 0.f, 0.f};
        int xo = 16 * g4; asm volatile("" : "+v"(xo));
#pragma unroll
        for (int c = 0; c < 8; ++c) { const v4i_t b0 = *(const LAS v4i_t*)(xl + xo + 128 * c), b1 = *(const LAS v4i_t*)(xl + xo + 128 * c + 64);
            const v8i_t av = {ua[c].x, ua[c].y, ua[c].z, ua[c].w, 0, 0, 0, 0}, bv = {b0.x, b0.y, b0.z, b0.w, b1.x, b1.y, b1.z, b1.w};
            acc = __builtin_amdgcn_mfma_scale_f32_16x16x128_f8f6f4(av, bv, acc, 4  , 0  , 0, 0x7F7F7F7F, 0, 0x7F7F7F7F); }
        const int isel = el & 3, je = 4 * g4 + isel;
        const float dsel = isel == 0 ? acc.x : isel == 1 ? acc.y : isel == 2 ? acc.z : acc.w;
        const float gate = shl_f(gsrc, base + je); const float hh = dsel * 0.5f * shl_f(ssrc, base + je);
        const float w = gate * 0.5f * hh * (1.f + erff(hh * 0.70710678118654752f));
        if (eb < 7) PK_LOADU(eb + 1);
#pragma unroll
        for (int j = 0; j < 16; ++j) { const float wj = __uint_as_float(__builtin_amdgcn_readlane(__float_as_uint(w), 16 * (j >> 2) + (j & 3)));
            axpy8_fp4(out, wj, qv[j].x); axpy8_fp4(out + 8, wj, qv[j].y); }
    }
#undef PK_LOADU
#undef PK_LOADV
#undef PK_IDX
    float* xr = xio + tok * 1024; f32x4 z[4]; float s = 0.f;
#pragma unroll
    for (int k = 0; k < 4; ++k) { const f32x4 xv = *(const GAS f32x4*)(xr + 256 * k + 4 * lane), gv = *(const GAS f32x4*)(gffn + 256 * k + 4 * lane);
        z[k].x = DN_ALPHA * xv.x + gv.x * out[4 * k]; z[k].y = DN_ALPHA * xv.y + gv.y * out[4 * k + 1]; z[k].z = DN_ALPHA * xv.z + gv.z * out[4 * k + 2]; z[k].w = DN_ALPHA * xv.w + gv.w * out[4 * k + 3];
        s += (z[k].x + z[k].y) + (z[k].z + z[k].w); }
    const float mean = wave_sum(s) * (1.f / DM); float s2 = 0.f;
#pragma unroll
    for (int k = 0; k < 4; ++k) { z[k] = z[k] - mean; s2 += (z[k].x * z[k].x + z[k].y * z[k].y) + (z[k].z * z[k].z + z[k].w * z[k].w); }
    const float rstd = 1.f / sqrtf(wave_sum(s2) * (1.f / DM) + LN_EPS);
    float s3 = 0.f;
#pragma unroll
    for (int k = 0; k < 4; ++k) { const f32x4 g = *(const GAS f32x4*)(lng + 256 * k + 4 * lane), bb = *(const GAS f32x4*)(lnb + 256 * k + 4 * lane);
        z[k] = z[k] * rstd * g + bb; *(GAS f32x4*)(xr + 256 * k + 4 * lane) = z[k]; s3 += (z[k].x + z[k].y) + (z[k].z + z[k].w); }
    if (mod_next) {
        const float mean3 = wave_sum(s3) * (1.f / DM); float s4 = 0.f;
#pragma unroll
        for (int k = 0; k < 4; ++k) { z[k] = z[k] - mean3; s4 += (z[k].x * z[k].x + z[k].y * z[k].y) + (z[k].z * z[k].z + z[k].w * z[k].w); }
        const float rstd3 = 1.f / sqrtf(wave_sum(s4) * (1.f / DM) + LN_EPS);
        GAS int* o4 = (GAS int*)(u8_next + tok * 1024) + lane;
#pragma unroll
        for (int k = 0; k < 4; ++k) { const f32x4 a = ((const GAS f32x4*)(mod_next + 1024))[lane + 64 * k], b = ((const GAS f32x4*)mod_next)[lane + 64 * k];
            f32x4 y = (z[k] * rstd3 * (a + 1.f) + b) * U8_SCALE; y.x = __builtin_amdgcn_fmed3f(y.x, -440.f, 440.f); y.y = __builtin_amdgcn_fmed3f(y.y, -440.f, 440.f); y.z = __builtin_amdgcn_fmed3f(y.z, -440.f, 440.f); y.w = __builtin_amdgcn_fmed3f(y.w, -440.f, 440.f);
            int wd = __builtin_amdgcn_cvt_pk_fp8_f32(y.x, y.y, 0, false); wd = __builtin_amdgcn_cvt_pk_fp8_f32(y.z, y.w, wd, true); o4[64 * k] = wd; }
    }
}

__device__ __forceinline__ void ln1_row(f32x4 (&v)[4], float* zrow, const float* g1, const float* b1, const float* sh, const float* sc, bf16* urow, int lane) {
    GAS f32x4* xr = (GAS f32x4*)zrow + lane;
    float s = 0.f;
#pragma unroll
    for (int j = 0; j < 4; ++j) { s += (v[j].x + v[j].y) + (v[j].z + v[j].w); }
    float mean = wave_sum(s) * (1.f / DM); float s2 = 0.f;
#pragma unroll
    for (int j = 0; j < 4; ++j) { v[j] = v[j] - mean; s2 += (v[j].x * v[j].x + v[j].y * v[j].y) + (v[j].z * v[j].z + v[j].w * v[j].w); }
    float rstd = 1.f / sqrtf(wave_sum(s2) * (1.f / DM) + LN_EPS);
    s = 0.f;
#pragma unroll
    for (int j = 0; j < 4; ++j) { const f32x4 g = ((const GAS f32x4*)g1)[lane + 64 * j], b = ((const GAS f32x4*)b1)[lane + 64 * j];
        v[j] = v[j] * rstd * g + b; xr[64 * j] = v[j]; s += (v[j].x + v[j].y) + (v[j].z + v[j].w); }
    mean = wave_sum(s) * (1.f / DM); s2 = 0.f;
#pragma unroll
    for (int j = 0; j < 4; ++j) { v[j] = v[j] - mean; s2 += (v[j].x * v[j].x + v[j].y * v[j].y) + (v[j].z * v[j].z + v[j].w * v[j].w); }
    rstd = 1.f / sqrtf(wave_sum(s2) * (1.f / DM) + LN_EPS);
    GAS unsigned long long* o8 = (GAS unsigned long long*)urow + lane;
#pragma unroll
    for (int j = 0; j < 4; ++j) { const f32x4 a = ((const GAS f32x4*)sc)[lane + 64 * j], b = ((const GAS f32x4*)sh)[lane + 64 * j];
        const f32x4 y = v[j] * rstd * (a + 1.f) + b;
        o8[64 * j] = (unsigned long long)pk2(y.x, y.y) | ((unsigned long long)pk2(y.z, y.w) << 32); }
}

#ifndef MK_MULTI
#define MK_MULTI 0
#endif
struct Args { const float* in[27]; float* out; unsigned char* ws; float inv64[32]; float inv32[16]; int ph_lo, ph_hi; };

__global__ void __launch_bounds__(NTHR, 2) fwd_kernel(Args args) {
    extern __shared__ __attribute__((aligned(16))) unsigned char lds_raw[];
    LAS unsigned char* lds = (LAS unsigned char*)lds_raw;
    volatile LAS unsigned* MISC = (volatile LAS unsigned*)(lds + MISC_OFF);
#define CAS __attribute__((address_space(4)))
#define PHASE_IDS const CAS Args* ka_ = (const CAS Args*)__builtin_amdgcn_kernarg_segment_ptr(); asm volatile("" : "+s"(ka_)); Ptrs P; \
    _Pragma("unroll") for (int i_ = 0; i_ < 27; ++i_) P.in[i_] = ka_->in[i_]; P.out = ka_->out; P.ws = ka_->ws; unsigned char* ws = P.ws; (void)ws; \
    int G = gridDim.x, bx = blockIdx.x; asm volatile("" : "+s"(G), "+s"(bx));   \
    const int vcu = (G % 8 == 0) ? (bx % 8) * (G / 8) + bx / 8 : bx;     \
    const int NGW = G * NWAVES; (void)NGW; \
    int tid = threadIdx.x; asm volatile("" : "+v"(tid)); const int lane = tid & 63, wave = __builtin_amdgcn_readfirstlane(tid >> 6); const int gw = vcu * NWAVES + wave; (void)lane; (void)gw;
    gu32* ctl = (gu32*)(args.ws + WS_CTL);
    for (int u = threadIdx.x; u < (LDS_BYTES - LDSCTL_OFF) / 4; u += NTHR) ((LAS unsigned*)(lds + LDSCTL_OFF))[u] = 0u;
    __syncthreads();
    const int lo = args.ph_lo, hi_ph = args.ph_hi;
    XcdBarrier bar; bar.bar = (unsigned*)(ctl + CW_BAR); bar.x = 0; bar.st = nullptr;
    if (hi_ph - lo > 1) bar = xcd_barrier_post((unsigned*)(ctl + CW_BAR), MISC + 8);
#ifndef PHASE_MASK
#define PHASE_MASK 0xFFF
#endif
#ifndef FL_VAR
#define FL_VAR 0
#endif
#ifndef FL_VAR_KINDS
#define FL_VAR_KINDS 3
#endif
#ifndef DUP_MASK
#define DUP_MASK 0
#endif
#ifndef ATT_MASK
#define ATT_MASK 15
#endif
#define PHON(j) (((PHASE_MASK) >> (j)) & 1)
#define IN(k) (lo <= (k) && (k) < hi_ph)
#define SEAM(k) do { if (IN(k) && IN((k) + 1)) xcd_barrier(bar); } while (0)

    if (PHON(11) && IN(0)) { PHASE_IDS
        compute_mod(P, lds, tid);
        compute_rope(P, (const float*)ka_->inv64, (const float*)ka_->inv32, vcu * NTHR + tid, G * NTHR);
        convert_weights(P, 0, lds, gw, NGW, wave, lane);
    }
    SEAM(0);

#pragma unroll
    for (int l = 0; l < DEPTH; ++l) {
        const int pb = 1 + 11 * l;
#define xin ((l == 0) ? P.in[0] : (const float*)P.out)
#define modl ((const float*)(ws + WS_MOD) + (size_t)l * 4 * 6144)
        if (PHON(0) && IN(pb + 0)) { PHASE_IDS
            if (l > 0) convert_weights(P, l, lds, gw, NGW, wave, lane);
            if (l == 0) for (int m = gw; m < T; m += NGW) { const float* mb = modl + (size_t)(m / SEQ) * 6144; f32x4 cur[4]; load_row(cur, xin + (size_t)m * DM, lane);
                ln_mod_row(cur, mb, mb + 1024, ws + WS_U + (size_t)m * DM, lane); }
        }
        SEAM(pb + 0);
        for (int rep_ = 0; rep_ < ((DUP_MASK >> 0) & 1) + 1; ++rep_) {
        if (PHON(1) && IN(pb + 1)) { PHASE_IDS
            pg8::Gemm g{(const bf16*)(ws + WS_U + (size_t)(l & 1) * 32 * MiB), (const bf16*)(ws + WS_WIN), T, NIN, 512, 512, 512}; pg8::StaticOrder S; S.init(T, NIN, G, bx);
            EpiInProj E{ws};
            pg8::gemm_phase<true>(lds, g, S, E);
        }
        SEAM(pb + 1);
        if (PHON(2) && IN(pb + 2)) { PHASE_IDS
            float* rstd = (float*)(ws + WS_RSTD);
            for (int m = gw; m < T; m += NGW) {
                const bf16* row = (const bf16*)(ws + WS_LAT) + (size_t)m * 768;
                float sq = 0.f, skv = 0.f;
                if (lane < 48) { const v4u a = *(const GAS v4u*)(row + 8 * lane);
                    sq = bf_lo(a.x) * bf_lo(a.x) + bf_hi(a.x) * bf_hi(a.x) + bf_lo(a.y) * bf_lo(a.y) + bf_hi(a.y) * bf_hi(a.y) + bf_lo(a.z) * bf_lo(a.z) + bf_hi(a.z) * bf_hi(a.z) + bf_lo(a.w) * bf_lo(a.w) + bf_hi(a.w) * bf_hi(a.w); }
                if (lane < 32) { const v4u a = *(const GAS v4u*)(row + 384 + 8 * lane);
                    skv = bf_lo(a.x) * bf_lo(a.x) + bf_hi(a.x) * bf_hi(a.x) + bf_lo(a.y) * bf_lo(a.y) + bf_hi(a.y) * bf_hi(a.y) + bf_lo(a.z) * bf_lo(a.z) + bf_hi(a.z) * bf_hi(a.z) + bf_lo(a.w) * bf_lo(a.w) + bf_hi(a.w) * bf_hi(a.w); }
                sq = wave_sum(sq); skv = wave_sum(skv);
                if (lane == 0) { rstd[2 * m] = 1.f / sqrtf(sq * (1.f / 384.f) + LN_EPS); rstd[2 * m + 1] = 1.f / sqrtf(skv * (1.f / 256.f) + LN_EPS); }
            }
        }
        SEAM(pb + 2);
        if (PHON(3) && IN(pb + 3)) { PHASE_IDS
            if (ATT_MASK & 1) { pg8::Gemm g{(const bf16*)(ws + WS_LAT), (const bf16*)(ws + WS_QUP), T, 768, 384, 768, 384}; pg8::StaticOrder S; S.init(T, 768, G, bx);
              EpiQup E{ws}; pg8::gemm_phase<false>(lds, g, S, E); }
            if (ATT_MASK & 2) { pg8::Gemm g{(const bf16*)(ws + WS_LAT) + 384, (const bf16*)(ws + WS_KVUP), T, 1024, 256, 768, 256}; pg8::StaticOrder S; S.init(T, 1024, G, bx);
              EpiScaleRow E{(bf16*)(ws + WS_KVB), 1024, (const float*)(ws + WS_RSTD) + 1, 2, 512, ws + WS_DIFV + 16 * MiB}; pg8::gemm_phase<false>(lds, g, S, E); }
        }
        SEAM(pb + 3);
        if (PHON(4) && IN(pb + 4)) { PHASE_IDS
            LAS float* bias_all = (LAS float*)(lds + LDSCTL_OFF + 1024);
            for (int i = tid; i < 8 * 465; i += NTHR) bias_all[i] = P.in[15][(size_t)l * 3720 + i] * LOG2E;
            const float lam_init = 0.8f - 0.6f * expf(-0.3f * (float)l);
            __syncthreads();
#if FL_VAR
            if (rep_ == 0 && DUP_MASK) {
                if (FL_VAR_KINDS & 1) for (int u = vcu; u < 16 * 32; u += G) { const int bh = u >> 5; diff_unit<FL_VAR>(ws, lds, bh >> 2, bh & 3, u & 31, wave, lane, P.in[10] + l * 64, P.in[11] + l * 64, P.in[12] + l * 64, P.in[13] + l * 64, lam_init, P.in[14] + l * 128); }
                if (FL_VAR_KINDS & 2) for (int u = vcu; u < 32 * 32; u += G) { const int bh = u >> 5; mla_unit<FL_VAR>(ws, lds, bh >> 3, bh & 7, u & 31, (l + 1) & 1, lane); }
                if (FL_VAR_KINDS & 4) for (int u = vcu; u < 32 * 32; u += G) { const int bh = u >> 5; swa_unit(ws, lds, bh >> 3, bh & 7, u & 31, (l + 1) & 1, lane, P.in[5][l * 8 + (bh & 7)] * LOG2E); }
                if (FL_VAR_KINDS & 8) for (int u = vcu; u < 32 * 32; u += G) { const int bh = u >> 5; nat_unit(ws, lds, bias_all, bh >> 3, bh & 7, u & 31, wave, lane); }
            } else {
#endif
            if (ATT_MASK & 1) for (int u = vcu; u < 16 * 32; u += G) { const int bh = u >> 5; diff_unit(ws, lds, bh >> 2, bh & 3, u & 31, wave, lane, P.in[10] + l * 64, P.in[11] + l * 64, P.in[12] + l * 64, P.in[13] + l * 64, lam_init, P.in[14] + l * 128); }
            if (ATT_MASK & 2) for (int u = vcu; u < 32 * 32; u += G) { const int bh = u >> 5; mla_unit(ws, lds, bh >> 3, bh & 7, u & 31, (l + 1) & 1, lane); }
            if (ATT_MASK & 4) for (int u = vcu; u < 32 * 32; u += G) { const int bh = u >> 5; swa_unit(ws, lds, bh >> 3, bh & 7, u & 31, (l + 1) & 1, lane, P.in[5][l * 8 + (bh & 7)] * LOG2E); }
            if (ATT_MASK & 8) for (int u = vcu; u < 32 * 32; u += G) { const int bh = u >> 5; nat_unit(ws, lds, bias_all, bh >> 3, bh & 7, u & 31, wave, lane); }
#if FL_VAR
            }
#endif
        }
        SEAM(pb + 4);
        }
        for (int rep_ = 0; rep_ < ((DUP_MASK >> 1) & 1) + 1; ++rep_) {
        if (PHON(5) && IN(pb + 5)) { PHASE_IDS
            for (int n = 0; n < 4; ++n) {
                { pg8::Gemm g{(const bf16*)(ws + WS_U + (size_t)(l & 1) * 32 * MiB), (const bf16*)(ws + WS_WG + (size_t)n * 1024 * 1024), T, 1024, 512, 512, 512}; pg8::StaticOrder S; S.init(T, 1024, G, bx);
                  EpiSigmoid E{ws + WS_SG}; pg8::gemm_phase<true>(lds, g, S, E); }
                const size_t ob = (n < 2) ? WS_U + (size_t)((l + 1) & 1) * 32 * MiB + (size_t)n * 16 * MiB : WS_LAT + (size_t)(n - 2) * 512;
                { pg8::Gemm g{(const bf16*)(ws + ob), (const bf16*)(ws + WS_WB + (size_t)n * 1024 * 512), T, 1024, 256, (n < 2) ? 256 : 768, 256}; pg8::StaticOrder S; S.init(T, 1024, G, bx);
                  EpiGated E{ws + WS_SG, ws + WS_SG + 32 * MiB, ws + WS_MERGED, n}; pg8::gemm_phase<true>(lds, g, S, E); }
            }
        }
        SEAM(pb + 5);
        }
        if (PHON(6) && IN(pb + 6)) { PHASE_IDS
            pg8::Gemm g{(const bf16*)(ws + WS_MERGED), (const bf16*)(ws + WS_WO), T, 1024, 512, 512, 512}; pg8::StaticOrder S; S.init(T, 1024, G, bx);
            EpiResid E{xin, P.out, modl + 2048}; pg8::gemm_phase<true>(lds, g, S, E);
        }
        SEAM(pb + 6);
        if (PHON(7) && IN(pb + 7)) { PHASE_IDS
            for (int m = gw; m < T; m += NGW) { const float* mb = modl + (size_t)(m / SEQ) * 6144; f32x4 cur[4]; load_row(cur, P.out + (size_t)m * DM, lane);
                ln1_row(cur, P.out + (size_t)m * DM, P.in[19] + l * 1024, P.in[20] + l * 1024, mb + 3072, mb + 4096, (bf16*)(ws + WS_U2) + (size_t)m * DM, lane); }
            const float* su = P.in[23] + (size_t)l * 16384 * 1024; const float* sv = P.in[24] + (size_t)l * 16384 * 1024;
            for (int r = gw; r < 2 * 16384; r += NGW) { const int tab = r >> 14, row = r & 16383; f32x4 cur[4]; load_row(cur, (tab ? sv : su) + (size_t)row * 1024, lane);
                if (tab) fp4_row(cur, ws + WS_VTAB + (size_t)row * 512, (float*)(ws + WS_TSCALE) + r, lane); else fp4_row_nat(cur, ws + WS_UTAB + (size_t)row * 512, (float*)(ws + WS_TSCALE) + r, lane); }
        }
        SEAM(pb + 7);
        for (int rep_ = 0; rep_ < ((DUP_MASK >> 2) & 1) + 1; ++rep_) {
        if (PHON(8) && IN(pb + 8)) { PHASE_IDS
            pg8::Gemm g{(const bf16*)(ws + WS_U2), (const bf16*)(ws + WS_WQ), T, 2048, 1024, 1024, 1024}; pg8::StaticOrder S; S.init(T, 2048, G, bx);
            EpiScaleRow E{(bf16*)(ws + WS_QP), 2048, nullptr, 0}; pg8::gemm_phase<false>(lds, g, S, E);
        }
        SEAM(pb + 8);
        if (PHON(9) && IN(pb + 9)) { PHASE_IDS
            { int last_h = -1; for (int u = vcu; u < (T / 256) * 8; u += G) { peer_route_unit(ws, lds, u >> 3, u & 7, wave, lane, (u & 7) != last_h); last_h = u & 7; } }
        }
        SEAM(pb + 9);
        }
        if (PHON(10) && IN(pb + 10)) { PHASE_IDS
            for (int m = gw; m < T; m += NGW) peer_token8(lds + wave * 1024, ws, P.out, modl + (size_t)(m / SEQ) * 6144 + 5120, P.in[25] + l * 1024, P.in[26] + l * 1024,
                                                       (l + 1 < DEPTH) ? modl + (size_t)(4 + m / SEQ) * 6144 : nullptr, ws + WS_U + (size_t)((l + 1) & 1) * 32 * MiB, (size_t)m, lane);
        }
        SEAM(pb + 10);
    }
#undef xin
#undef modl
#undef IN
#undef SEAM
}

extern "C" void kernel_launch(void* const* d_in, const int* in_sizes, int n_in, void* d_out, int out_size, void* d_ws, size_t ws_size, hipStream_t stream) {
    static int grid = 0;
    if (grid == 0) {
        if (n_in != 27 || out_size != T * DM || ws_size < WS_END) { fprintf(stderr, "kernel_launch: unexpected problem (n_in %d, out %d, ws %zu < %zu?)\n", n_in, out_size, ws_size, (size_t)WS_END); grid = -1; return; }
        int dev = 0, cus = 0, per_cu = 0;
        if (hipGetDevice(&dev) != hipSuccess || hipDeviceGetAttribute(&cus, hipDeviceAttributeMultiprocessorCount, dev) != hipSuccess) { grid = -1; return; }
        if (hipFuncSetAttribute((const void*)fwd_kernel, hipFuncAttributeMaxDynamicSharedMemorySize, LDS_BYTES) != hipSuccess) { fprintf(stderr, "kernel_launch: hipFuncSetAttribute failed\n"); grid = -1; return; }
        if (hipOccupancyMaxActiveBlocksPerMultiprocessor(&per_cu, (const void*)fwd_kernel, NTHR, LDS_BYTES) != hipSuccess || per_cu < 1) { fprintf(stderr, "kernel_launch: occupancy query says %d\n", per_cu); }
        (void)hipGetLastError();
        grid = cus < 256 ? cus : 256;
        fprintf(stderr, "kernel_launch: grid %d, ws %zu MiB\n", grid, ws_size >> 20);
    }
    if (grid < 0) return;
    (void)hipMemsetAsync((char*)d_ws + WS_CTL, 0, CTL_ZERO_BYTES, stream);
    Args a{};
    for (int i = 0; i < 27; ++i) a.in[i] = (const float*)d_in[i];
    a.out = (float*)d_out; a.ws = (unsigned char*)d_ws;
    for (int i = 0; i < 32; ++i) a.inv64[i] = (float)pow(10000.0, -(double)(2 * i) / 64.0);
    for (int i = 0; i < 16; ++i) a.inv32[i] = (float)pow(10000.0, -(double)(2 * i) / 32.0);
#if MK_MULTI
    for (int k = 0; k < NPHASE; ++k) { a.ph_lo = k; a.ph_hi = k + 1; hipLaunchKernelGGL(fwd_kernel, dim3(grid), dim3(NTHR), LDS_BYTES, stream, a); }
#else
    a.ph_lo = 0; a.ph_hi = NPHASE; hipLaunchKernelGGL(fwd_kernel, dim3(grid), dim3(NTHR), LDS_BYTES, stream, a);
#endif
}
```
